# Optimizing an MI355X kernel written in HIP

```python
import math
import jax, jax.numpy as jnp
from jax import lax
import numpy as np

D_MODEL = 4096
BATCH = 1
SEQ = 8192
DEPTH = 2

HEAD_DIM = 128
N_HEADS = D_MODEL // HEAD_DIM
DILATED_PATTERNS = ((128, 1), (512, 4), (2048, 16))
N_GROUPS_A = len(DILATED_PATTERNS)
BAND_BLOCK = 128
MOBA_BLOCK = 256
MOBA_TOPK = 3
Q_CHUNK = 64
N_BUCKETS = 32
MAX_DISTANCE = 2048
D_FF = -(-8 * D_MODEL // (3 * 256)) * 256
N_A_LAYERS = DEPTH // 2
N_B_LAYERS = DEPTH - N_A_LAYERS
EPS = 1e-6
NEG = -1e30

kernel_name = "yoco_dilated_moba_hybrid"


def rms_norm(x, g):
    xf = x.astype(jnp.float32)
    y = xf * lax.rsqrt(jnp.mean(xf * xf, axis=-1, keepdims=True) + EPS)
    return (y * g.astype(jnp.float32)).astype(x.dtype)


def head_rms(t, g):
    t = t.astype(jnp.float32)
    return t * lax.rsqrt(jnp.mean(t * t, axis=-1, keepdims=True) + EPS) * g.astype(jnp.float32)


def rel_bucket(dist):
    n = jnp.maximum(dist, 0)
    exact = N_BUCKETS // 2
    nf = jnp.maximum(n, exact).astype(jnp.float32)
    large = exact + (jnp.log(nf / exact) / math.log(MAX_DISTANCE / exact)
                     * (N_BUCKETS - exact)).astype(jnp.int32)
    return jnp.where(n < exact, n, jnp.minimum(large, N_BUCKETS - 1))


def masked_softmax(logits, valid):
    logits = jnp.where(valid, logits, NEG)
    m = jnp.max(logits, axis=-1, keepdims=True)
    p = jnp.exp(logits - m)
    s = jnp.sum(p, axis=-1, keepdims=True)
    return p / s, (m + jnp.log(s))[..., 0]


def dilated_branch(q, k, v, rel_bias, window, dilation):
    B, S, H, dh = q.shape
    L = S // dilation
    nb = -(-L // BAND_BLOCK)
    Lp = nb * BAND_BLOCK
    w_sub = window // dilation

    def to_residue(t):
        t = t.reshape(B, L, dilation, H, dh)
        t = jnp.moveaxis(t, 2, 1).reshape(B * dilation, L, H, dh)
        t = jnp.pad(t, ((0, 0), (0, Lp - L), (0, 0), (0, 0)))
        return t.reshape(B * dilation, nb, BAND_BLOCK, H, dh)

    def with_prev(t):
        prev = jnp.pad(t[:, :-1], ((0, 0), (1, 0), (0, 0), (0, 0), (0, 0)))
        return jnp.concatenate([prev, t], axis=2)

    qb = to_residue(q)
    kk = with_prev(to_residue(k))
    vv = with_prev(to_residue(v))

    i = jnp.arange(BAND_BLOCK)[:, None]
    j = jnp.arange(2 * BAND_BLOCK)[None, :]
    dist = BAND_BLOCK + i - j
    band_ok = (dist >= 0) & (dist <= w_sub)
    first_ok = (jnp.arange(nb)[:, None] * BAND_BLOCK - BAND_BLOCK
                + jnp.arange(2 * BAND_BLOCK)[None, :]) >= 0
    valid = (band_ok[None] & first_ok[:, None, :])[None, :, None]
    bias = jnp.transpose(rel_bias.astype(jnp.float32)[rel_bucket(dist * dilation)], (2, 0, 1))

    logits = jnp.einsum('bnqhd,bnkhd->bnhqk', qb, kk) * (HEAD_DIM ** -0.5) + bias[None, None]
    p, lse = masked_softmax(logits, valid)
    out = jnp.einsum('bnhqk,bnkhd->bnqhd', p, vv)
    lse = jnp.moveaxis(lse, 2, 3)

    def from_residue(t):
        rest = t.shape[3:]
        t = t.reshape((B, dilation, Lp) + rest)[:, :, :L]
        t = jnp.moveaxis(t, 1, 2)
        return t.reshape((B, S) + rest)

    return from_residue(out), from_residue(lse)


def dilated_mixer(h, w_qkv, q_gain, k_gain, w_o, rel_bias):
    B, S, _ = h.shape
    proj = (h @ w_qkv).astype(jnp.float32)
    nq = N_GROUPS_A * D_MODEL
    q = proj[..., :nq].reshape(B, S, N_GROUPS_A, N_HEADS, HEAD_DIM)
    k = proj[..., nq:nq + D_MODEL].reshape(B, S, N_HEADS, HEAD_DIM)
    v = proj[..., nq + D_MODEL:].reshape(B, S, N_HEADS, HEAD_DIM)
    q = head_rms(q, q_gain[:, None, :])
    k = head_rms(k, k_gain)
    outs, lses = [], []
    for g, (window, dilation) in enumerate(DILATED_PATTERNS):
        o, l = dilated_branch(q[:, :, g], k, v, rel_bias, window, dilation)
        outs.append(o)
        lses.append(l)
    wts = jax.nn.softmax(jnp.stack(lses), axis=0)
    o = jnp.sum(wts[..., None] * jnp.stack(outs), axis=0).reshape(B, S, D_MODEL)
    return o.astype(h.dtype) @ w_o


def shared_kv(x, kv_norm, w_kv, k_gain):
    B, S, _ = x.shape
    nb = -(-S // MOBA_BLOCK)
    Sp = nb * MOBA_BLOCK
    kv = (rms_norm(x, kv_norm) @ w_kv).astype(jnp.float32)
    k = head_rms(kv[..., :D_MODEL].reshape(B, S, N_HEADS, HEAD_DIM), k_gain)
    v = kv[..., D_MODEL:].reshape(B, S, N_HEADS, HEAD_DIM)
    pad = ((0, 0), (0, Sp - S), (0, 0), (0, 0))
    kp = jnp.pad(k, pad).reshape(B, nb, MOBA_BLOCK, N_HEADS, HEAD_DIM)
    vp = jnp.pad(v, pad).reshape(B, nb, MOBA_BLOCK, N_HEADS, HEAD_DIM)
    kmean = jnp.mean(kp, axis=2)
    return kp, vp, kmean


def moba_attention(q, kp, vp, kmean, rel_bias):
    B, S, H, dh = q.shape
    nb = kp.shape[1]
    Sp = nb * MOBA_BLOCK
    n_sel = min(MOBA_TOPK, nb)
    scale = HEAD_DIM ** -0.5
    rb = rel_bias.astype(jnp.float32)
    t = jnp.arange(S)
    cur = t // MOBA_BLOCK

    gate = jnp.einsum('bshd,bnhd->bhsn', q, kmean)
    past = jnp.arange(nb)[None, :] < cur[:, None]
    gate = jnp.where(past, gate, NEG)
    _, sel = lax.top_k(gate, n_sel)
    sel = jnp.transpose(sel, (0, 2, 1, 3))

    qo = jnp.pad(q, ((0, 0), (0, Sp - S), (0, 0), (0, 0))).reshape(B, nb, MOBA_BLOCK, H, dh)
    i = jnp.arange(MOBA_BLOCK)[:, None]
    j = jnp.arange(MOBA_BLOCK)[None, :]
    bias_own = jnp.transpose(rb[rel_bucket(i - j)], (2, 0, 1))
    own_logits = jnp.einsum('bnqhd,bnkhd->bnhqk', qo, kp) * scale + bias_own[None, None]
    p_own, lse_own = masked_softmax(own_logits, j <= i)
    out_own = jnp.einsum('bnhqk,bnkhd->bnqhd', p_own, vp).reshape(B, Sp, H, dh)[:, :S]
    lse_own = jnp.moveaxis(lse_own, 2, 3).reshape(B, Sp, H)[:, :S]

    kbh = jnp.moveaxis(kp, 3, 1)
    vbh = jnp.moveaxis(vp, 3, 1)
    bias_tab = rb.T
    b_ix = jnp.arange(B)[:, None, None]
    h_ix = jnp.arange(H)[None, :, None]
    n_chunks = S // Q_CHUNK

    def to_chunks(a):
        return jnp.moveaxis(a.reshape((B, n_chunks, Q_CHUNK) + a.shape[2:]), 1, 0)

    def step(args):
        q_c, sel_c, t_c, lse_o, out_o = args
        cur_c = t_c // MOBA_BLOCK
        lses, outs = [lse_o], [out_o]
        for s in range(n_sel):
            blk = jnp.transpose(sel_c[..., s], (0, 2, 1))
            kg = kbh[b_ix, h_ix, blk]
            vg = vbh[b_ix, h_ix, blk]
            kpos = blk[..., None] * MOBA_BLOCK + jnp.arange(MOBA_BLOCK)
            bias = bias_tab[h_ix[..., None], rel_bucket(t_c[:, None] - kpos)]
            logits = jnp.einsum('bqhd,bhqkd->bhqk', q_c, kg) * scale + bias
            ok = (s < cur_c)[None, None, :, None]
            p, lse = masked_softmax(logits, ok)
            lse = jnp.where(ok[..., 0], lse, NEG)
            outs.append(jnp.einsum('bhqk,bhqkd->bqhd', p, vg))
            lses.append(jnp.transpose(lse, (0, 2, 1)))
        w = jax.nn.softmax(jnp.stack(lses), axis=0)
        return jnp.sum(w[..., None] * jnp.stack(outs), axis=0)

    res = lax.map(step, (to_chunks(q), to_chunks(sel), t.reshape(n_chunks, Q_CHUNK),
                         to_chunks(lse_own), to_chunks(out_own)))
    return jnp.moveaxis(res, 0, 1).reshape(B, S, H, dh)


def moba_mixer(h, w_q, q_gain, w_o, kp, vp, kmean, rel_bias):
    B, S, _ = h.shape
    q = head_rms((h @ w_q).astype(jnp.float32).reshape(B, S, N_HEADS, HEAD_DIM), q_gain)
    o = moba_attention(q, kp, vp, kmean, rel_bias).reshape(B, S, D_MODEL)
    return o.astype(h.dtype) @ w_o


def swiglu(h, w_gate_up, w_down):
    gu = h @ w_gate_up
    return (jax.nn.silu(gu[..., :D_FF]) * gu[..., D_FF:]) @ w_down


def setup_inputs(seed: int = 0) -> dict:
    key = jax.random.key(seed)
    ks = jax.random.split(key, 16)
    f32 = jnp.float32

    def nrm(k, shape, scale):
        return jax.random.normal(k, shape, f32) * scale

    def gain(k, shape):
        return 1.0 + 0.02 * jax.random.normal(k, shape, f32)

    d = D_MODEL
    return {
        "x": nrm(ks[0], (BATCH, SEQ, d), 1.0),
        "rel_bias": nrm(ks[1], (N_BUCKETS, N_HEADS), 0.1),
        "attn_norm": gain(ks[2], (DEPTH, d)),
        "ffn_norm": gain(ks[3], (DEPTH, d)),
        "w_qkv_a": nrm(ks[4], (N_A_LAYERS, d, (N_GROUPS_A + 2) * d), d ** -0.5),
        "q_norm_a": gain(ks[5], (N_A_LAYERS, N_GROUPS_A, HEAD_DIM)),
        "k_norm_a": gain(ks[6], (N_A_LAYERS, HEAD_DIM)),
        "w_o_a": nrm(ks[7], (N_A_LAYERS, d, d), d ** -0.5),
        "kv_norm": gain(ks[8], (d,)),
        "w_kv_b": nrm(ks[9], (d, 2 * d), d ** -0.5),
        "k_norm_b": gain(ks[10], (HEAD_DIM,)),
        "w_q_b": nrm(ks[11], (N_B_LAYERS, d, d), d ** -0.5),
        "q_norm_b": gain(ks[12], (N_B_LAYERS, HEAD_DIM)),
        "w_o_b": nrm(ks[13], (N_B_LAYERS, d, d), d ** -0.5),
        "w_gate_up": nrm(ks[14], (DEPTH, d, 2 * D_FF), d ** -0.5),
        "w_down": nrm(ks[15], (DEPTH, D_FF, d), D_FF ** -0.5),
    }


def reference(x, rel_bias, attn_norm, ffn_norm, w_qkv_a, q_norm_a, k_norm_a, w_o_a,
              kv_norm, w_kv_b, k_norm_b, w_q_b, q_norm_b, w_o_b, w_gate_up, w_down):
    for l in range(DEPTH):
        if l < N_A_LAYERS:
            x = x + dilated_mixer(rms_norm(x, attn_norm[l]), w_qkv_a[l], q_norm_a[l],
                                  k_norm_a[l], w_o_a[l], rel_bias)
        else:
            if l == N_A_LAYERS:
                kp, vp, kmean = shared_kv(x, kv_norm, w_kv_b, k_norm_b)
            i = l - N_A_LAYERS
            x = x + moba_mixer(rms_norm(x, attn_norm[l]), w_q_b[i], q_norm_b[i], w_o_b[i],
                               kp, vp, kmean, rel_bias)
        x = x + swiglu(rms_norm(x, ffn_norm[l]), w_gate_up[l], w_down[l])
    return x
```

```cpp
#include <hip/hip_runtime.h>
#include <cstdio>
#include <cstdint>
namespace pg8 {
#define PG8_LAS __attribute__((address_space(3)))
typedef unsigned short bf16_t;
typedef short bf16x8 __attribute__((ext_vector_type(8)));
typedef float f32x4 __attribute__((ext_vector_type(4)));
typedef unsigned u32x4 __attribute__((ext_vector_type(4)));
constexpr int BM = 256, BK = 64, HALF = 128, HTB = HALF * BK * 2  , STAGE_BYTES = 8 * HTB, NXCD = 8, WGM = 8;

__host__ __device__ __forceinline__ int lds_byte(int r, int c) { const int st = (r >> 4) * 2 + (c >> 5), rr = r & 15, cc = c & 31, ob = rr * 64 + cc * 2; return st * 1024 + (ob ^ (((ob >> 9) & 1) << 5)); }
__host__ __device__ __forceinline__ void stage_rc(int b, int& R, int& C) { const int st = b / 1024, sb = b % 1024, swz = sb ^ (((sb >> 9) & 1) << 5); R = (st >> 1) * 16 + swz / 64; C = (st & 1) * 32 + (swz % 64) / 2; }
__host__ __device__ __forceinline__ int perm32(int rho) { const int n = rho >> 4, i = rho & 15; return 8 * (i >> 2) + 4 * n + (i & 3); }

struct Unit { int pm, pn; };
struct Gemm { const bf16_t* A; const bf16_t* Bt; int M, N, K; };

struct StaticOrder {
    int nM, nN, nwg, G, c;
    __host__ __device__ void init(int M, int N, int G_, int c_) { nM = M / BM; nN = N / BM; nwg = nM * nN; G = G_; c = c_; }
    __host__ __device__ bool next(int i, Unit& u) const {
        const long L = (long)i * G + c; if (L >= nwg) return false;
        int wgid = (int)L; { const int q = nwg / NXCD, r = nwg % NXCD, xcd = wgid % NXCD, off = wgid / NXCD; wgid = (xcd < r ? xcd * (q + 1) : r * (q + 1) + (xcd - r) * q) + off; }
        const int nig = WGM * nN, gid = wgid / nig, fm = gid * WGM, gsz = (nM - fm) < WGM ? (nM - fm) : WGM;
        u.pm = fm + ((wgid % nig) % gsz); u.pn = (wgid % nig) / gsz; return true;
    }
    __device__ __forceinline__ void a_ready(const Unit&) const {}
    __device__ __forceinline__ void done(const Unit&) const {}
};

__device__ __forceinline__ unsigned cvt_pk_bf16(float lo, float hi) { unsigned r; asm volatile("v_cvt_pk_bf16_f32 %0, %1, %2" : "=v"(r) : "v"(lo), "v"(hi)); return r; }
typedef float f32x2 __attribute__((ext_vector_type(2)));

constexpr float RMS_EPS = 1e-6f;
struct EpiHeadNorm {
    static constexpr bool PERM = true, AFTER_DRAIN = false;
    bf16_t* O; int ldc; int n_q, q_shift, n_k; const float* gq; const float* gk; float qscale; float* kmean; PG8_LAS float* X;
    __device__ __forceinline__ void operator()(const f32x4 (&acc)[2][2][4][2], const Unit& u, int wr, int wc, int fr, int fq) const {
        const int pn = u.pn, row0 = u.pm * BM + wr * 64 + fr, col0 = pn * BM + wc * 32 + 8 * fq;
        if (pn >= n_q + n_k) {
#pragma unroll
            for (int ai = 0; ai < 2; ++ai)
#pragma unroll
                for (int m = 0; m < 4; ++m) { bf16_t* rowp = O + (size_t)(row0 + ai * HALF + m * 16) * ldc + col0;
#pragma unroll
                    for (int bj = 0; bj < 2; ++bj) { const f32x4 v0 = acc[ai][bj][m][0], v1 = acc[ai][bj][m][1];
                        u32x4 w; w.x = cvt_pk_bf16(v0[0], v0[1]); w.y = cvt_pk_bf16(v0[2], v0[3]); w.z = cvt_pk_bf16(v1[0], v1[1]); w.w = cvt_pk_bf16(v1[2], v1[3]);
                        *(u32x4*)(rowp + bj * HALF) = w; } }
            return;
        }
        const bool isq = pn < n_q;
        const float* g = isq ? gq + (pn >> q_shift) * 128 : gk;
        const float sc = isq ? qscale : 1.f;
#pragma unroll
        for (int ai = 0; ai < 2; ++ai)
#pragma unroll
            for (int bj = 0; bj < 2; ++bj)
#pragma unroll
                for (int m = 0; m < 4; ++m) { const f32x4 a = acc[ai][bj][m][0], b = acc[ai][bj][m][1];
                    float s = ((a[0] * a[0] + a[1] * a[1]) + (a[2] * a[2] + a[3] * a[3])) + ((b[0] * b[0] + b[1] * b[1]) + (b[2] * b[2] + b[3] * b[3]));
                    s += __shfl_xor(s, 16); s += __shfl_xor(s, 32);
                    if (fq == 0) X[((ai * HALF + wr * 64 + m * 16 + fr) * 2 + bj) * 4 + wc] = s; }
        asm volatile("s_waitcnt lgkmcnt(0)" ::: "memory"); __builtin_amdgcn_s_barrier(); asm volatile("" ::: "memory");
        const f32x4 g0 = *(const f32x4*)(g + wc * 32 + 8 * fq), g1 = *(const f32x4*)(g + wc * 32 + 8 * fq + 4);
        f32x4 cs[2][2];
#pragma unroll
        for (int bj = 0; bj < 2; ++bj) { cs[bj][0] = (f32x4){0.f, 0.f, 0.f, 0.f}; cs[bj][1] = (f32x4){0.f, 0.f, 0.f, 0.f}; }
#pragma unroll
        for (int ai = 0; ai < 2; ++ai)
#pragma unroll
            for (int m = 0; m < 4; ++m) { bf16_t* rowp = O + (size_t)(row0 + ai * HALF + m * 16) * ldc + col0;
#pragma unroll
                for (int bj = 0; bj < 2; ++bj) { const f32x4 p = *(const PG8_LAS f32x4*)(X + ((ai * HALF + wr * 64 + m * 16 + fr) * 2 + bj) * 4);
                    const float rs = __builtin_amdgcn_rsqf(((p[0] + p[1]) + (p[2] + p[3])) * (1.0f / 128.0f) + RMS_EPS) * sc;
                    const f32x4 v0 = acc[ai][bj][m][0] * rs * g0, v1 = acc[ai][bj][m][1] * rs * g1;
                    cs[bj][0] += v0; cs[bj][1] += v1;
                    u32x4 w; w.x = cvt_pk_bf16(v0[0], v0[1]); w.y = cvt_pk_bf16(v0[2], v0[3]); w.z = cvt_pk_bf16(v1[0], v1[1]); w.w = cvt_pk_bf16(v1[2], v1[3]);
                    *(u32x4*)(rowp + bj * HALF) = w; } }
        if (kmean != nullptr && !isq) {
#pragma unroll
            for (int bj = 0; bj < 2; ++bj)
#pragma unroll
                for (int n = 0; n < 2; ++n)
#pragma unroll
                    for (int j = 0; j < 4; ++j) { float s = cs[bj][n][j];
                        s += __shfl_xor(s, 1); s += __shfl_xor(s, 2); s += __shfl_xor(s, 4); s += __shfl_xor(s, 8);
                        if (fr == 0) atomicAdd(kmean + (size_t)u.pm * 4096 + (pn - n_q) * BM + bj * HALF + wc * 32 + 8 * fq + 4 * n + j, s * (1.0f / 256.0f)); }
        }
    }
};
struct EpiResF32 {
    static constexpr bool PERM = false, AFTER_DRAIN = false;
    const float* base; float* out; int ldc;
    __device__ __forceinline__ void operator()(const f32x4 (&acc)[2][2][4][2], const Unit& u, int wr, int wc, int fr, int fq) const {
        const int row0 = u.pm * BM + wr * 64 + fr, col0 = u.pn * BM + wc * 32 + 4 * fq;
#pragma unroll
        for (int ai = 0; ai < 2; ++ai)
#pragma unroll
            for (int m = 0; m < 4; ++m) { const size_t off = (size_t)(row0 + ai * HALF + m * 16) * ldc + col0;
                f32x4 bs[2][2];
#pragma unroll
                for (int bj = 0; bj < 2; ++bj)
#pragma unroll
                    for (int n = 0; n < 2; ++n) bs[bj][n] = *(const f32x4*)(base + off + bj * HALF + n * 16);
#pragma unroll
                for (int bj = 0; bj < 2; ++bj)
#pragma unroll
                    for (int n = 0; n < 2; ++n) *(f32x4*)(out + off + bj * HALF + n * 16) = bs[bj][n] + acc[ai][bj][m][n];
                asm volatile("" ::: "memory"); }
    }
};
struct EpiSwiGLU {
    static constexpr bool PERM = true, AFTER_DRAIN = false;
    bf16_t* H; int ldh;
    static __device__ __forceinline__ float sw(float g, float up) { return g * up * __builtin_amdgcn_rcpf(1.0f + __builtin_amdgcn_exp2f(g * -1.4426950408889634f)); }
    __device__ __forceinline__ void operator()(const f32x4 (&acc)[2][2][4][2], const Unit& u, int wr, int wc, int fr, int fq) const {
        const int row0 = u.pm * BM + wr * 64 + fr, col0 = u.pn * HALF + wc * 32 + 8 * fq;
#pragma unroll
        for (int ai = 0; ai < 2; ++ai)
#pragma unroll
            for (int m = 0; m < 4; ++m) { const f32x4 ga = acc[ai][0][m][0], gb = acc[ai][0][m][1], ua = acc[ai][1][m][0], ub = acc[ai][1][m][1];
                u32x4 w; w.x = cvt_pk_bf16(sw(ga[0], ua[0]), sw(ga[1], ua[1])); w.y = cvt_pk_bf16(sw(ga[2], ua[2]), sw(ga[3], ua[3]));
                w.z = cvt_pk_bf16(sw(gb[0], ub[0]), sw(gb[1], ub[1])); w.w = cvt_pk_bf16(sw(gb[2], ub[2]), sw(gb[3], ub[3]));
                *(u32x4*)(H + (size_t)(row0 + ai * HALF + m * 16) * ldh + col0) = w; }
    }
};

template <class Epi, class Sched, bool ALIGN_EPI = false, bool SP2 = false>
__device__ __forceinline__ void gemm_phase(PG8_LAS unsigned char* lds, const Gemm g, const Sched& S, const Epi& E) {
    const int tid = threadIdx.x, wid = __builtin_amdgcn_readfirstlane(tid >> 6), lane = tid & 63, wr = wid >> 2, wc = wid & 3, fr = lane & 15, fq = lane >> 4;
    const int K = g.K, nt = K / BK;
    unsigned voffA[2], voffB[2];
#pragma unroll
    for (int i = 0; i < 2; ++i) { int R, C; stage_rc(tid * 16 + i * 8192, R, C); const int Rb = Epi::PERM ? ((R & ~31) + perm32(R & 31)) : R;
        voffA[i] = (unsigned)(R * K + C) * 2u; voffB[i] = (unsigned)(Rb * K + C) * 2u; }
    const size_t kstep = (size_t)(BK * 2);
    const size_t hstep = (size_t)HALF * K * 2;
    const size_t tstep = 2 * hstep;
    const unsigned ldsw = (unsigned)wid * 1024u;
    const int aoff = lds_byte(wr * 64 + fr, fq * 8), boff = lds_byte(wc * 32 + fr, fq * 8);
#define PG8_SA(b, h) (((b) * 2 + (h)) * HTB)
#define PG8_SB(b, h) ((4 + (b) * 2 + (h)) * HTB)
#define PG8_STAGE(bufoff, gbase, voff) do { _Pragma("unroll") for (int _i = 0; _i < 2; ++_i) \
        __builtin_amdgcn_global_load_lds((const unsigned*)((const char*)(gbase) + (voff)[_i]), (PG8_LAS unsigned*)(lds + (bufoff) + ldsw + _i * 8192), 16, 0, 0); } while (0)
#define PG8_LDA(dst, b, h) do { _Pragma("unroll") for (int m = 0; m < 4; ++m) _Pragma("unroll") for (int k = 0; k < 2; ++k) dst[m][k] = *(const PG8_LAS bf16x8*)(lds + PG8_SA(b, h) + aoff + m * 2048 + k * 1024); } while (0)
#define PG8_LDB(dst, b, h) do { _Pragma("unroll") for (int n = 0; n < 2; ++n) _Pragma("unroll") for (int k = 0; k < 2; ++k) dst[n][k] = *(const PG8_LAS bf16x8*)(lds + PG8_SB(b, h) + boff + n * 2048 + k * 1024); } while (0)
#define PG8_MMA(ai, bj, At, Bt) do { __builtin_amdgcn_s_setprio(1); _Pragma("unroll") for (int m = 0; m < 4; ++m) _Pragma("unroll") for (int n = 0; n < 2; ++n) _Pragma("unroll") for (int k = 0; k < 2; ++k) \
        acc[ai][bj][m][n] = __builtin_amdgcn_mfma_f32_16x16x32_bf16(Bt[n][k], At[m][k], acc[ai][bj][m][n], 0, 0, 0); __builtin_amdgcn_s_setprio(0); } while (0)
#define PG8_WAIT_V(n) asm volatile("s_waitcnt vmcnt(" #n ")" ::: "memory")
#define PG8_WAIT_L(n) asm volatile("s_waitcnt lgkmcnt(" #n ")" ::: "memory")
#define PG8_BAR __builtin_amdgcn_s_barrier()
#define PG8_SCHED __builtin_amdgcn_sched_barrier(0)
    Unit cur, nxt; int ui = 0;
    if (!S.next(0, cur)) return;
    f32x4 acc[2][2][4][2];
#pragma unroll
    for (int a = 0; a < 2; ++a)
#pragma unroll
        for (int b = 0; b < 2; ++b)
#pragma unroll
            for (int m = 0; m < 4; ++m)
#pragma unroll
                for (int n = 0; n < 2; ++n) acc[a][b][m][n] = (f32x4){0.f, 0.f, 0.f, 0.f};
    bf16x8 At[4][2], B0[2][2], B1[2][2];
    const char* cA = (const char*)g.A + (size_t)cur.pm * tstep; const char* cB = (const char*)g.Bt + (size_t)cur.pn * tstep;
    S.a_ready(cur);
    if constexpr (SP2) {
        PG8_STAGE(PG8_SB(0, 0), cB, voffB); PG8_STAGE(PG8_SB(0, 1), cB + hstep, voffB); PG8_STAGE(PG8_SA(0, 0), cA, voffA); PG8_STAGE(PG8_SA(0, 1), cA + hstep, voffA);
        if (wr == 1) PG8_BAR;
        PG8_WAIT_V(2); PG8_BAR;
        PG8_STAGE(PG8_SB(1, 0), cB + kstep, voffB); PG8_STAGE(PG8_SA(1, 0), cA + kstep, voffA); PG8_STAGE(PG8_SB(1, 1), cB + hstep + kstep, voffB);
        PG8_WAIT_V(6); PG8_BAR;
    } else {
        PG8_STAGE(PG8_SB(0, 0), cB, voffB); PG8_STAGE(PG8_SA(0, 0), cA, voffA); PG8_STAGE(PG8_SB(0, 1), cB + hstep, voffB); PG8_STAGE(PG8_SA(0, 1), cA + hstep, voffA);
        if (wr == 1) PG8_BAR;
        PG8_WAIT_V(4); PG8_BAR;
        PG8_STAGE(PG8_SB(1, 0), cB + kstep, voffB); PG8_STAGE(PG8_SA(1, 0), cA + kstep, voffA); PG8_STAGE(PG8_SB(1, 1), cB + hstep + kstep, voffB);
        PG8_WAIT_V(6); PG8_BAR;
    }
    for (;;) {
        const bool has_next = S.next(ui + 1, nxt);
        const char* nA = has_next ? (const char*)g.A + (size_t)nxt.pm * tstep : cA; const char* nB = has_next ? (const char*)g.Bt + (size_t)nxt.pn * tstep : cB;
        for (int t = 0; t < nt; t += 2) {
            const bool last = (t == nt - 2);
            const char* a1 = cA + (size_t)(t + 1) * kstep;
            const char* a2 = last ? nA : cA + (size_t)(t + 2) * kstep; const char* b2 = last ? nB : cB + (size_t)(t + 2) * kstep;
            const char* a3 = a2 + kstep; const char* b3 = b2 + kstep;
            if (last && has_next) S.a_ready(nxt);
            if constexpr (SP2) {
            PG8_LDB(B0, 0, 0); PG8_LDB(B1, 0, 1); PG8_SCHED; PG8_LDA(At, 0, 0); PG8_STAGE(PG8_SA(1, 1), a1 + hstep, voffA);
            PG8_WAIT_V(8); PG8_WAIT_L(0); PG8_BAR; PG8_MMA(0, 0, At, B0); PG8_MMA(0, 1, At, B1); PG8_BAR; PG8_SCHED;
            PG8_LDA(At, 0, 1); PG8_STAGE(PG8_SB(0, 0), b2, voffB); PG8_STAGE(PG8_SB(0, 1), b2 + hstep, voffB); PG8_STAGE(PG8_SA(0, 0), a2, voffA);
            PG8_WAIT_V(8); PG8_WAIT_L(0); PG8_BAR; PG8_MMA(1, 0, At, B0); PG8_MMA(1, 1, At, B1); PG8_BAR; PG8_SCHED;
            PG8_LDB(B0, 1, 0); PG8_LDB(B1, 1, 1); PG8_SCHED; PG8_LDA(At, 1, 0); PG8_STAGE(PG8_SA(0, 1), a2 + hstep, voffA);
            PG8_WAIT_V(8); PG8_WAIT_L(0); PG8_BAR; PG8_MMA(0, 0, At, B0); PG8_MMA(0, 1, At, B1); PG8_BAR; PG8_SCHED;
            PG8_LDA(At, 1, 1); PG8_STAGE(PG8_SB(1, 0), b3, voffB); PG8_STAGE(PG8_SB(1, 1), b3 + hstep, voffB); PG8_STAGE(PG8_SA(1, 0), a3, voffA);
            PG8_WAIT_V(8); PG8_WAIT_L(0); PG8_BAR; PG8_MMA(1, 0, At, B0); PG8_MMA(1, 1, At, B1); PG8_BAR; PG8_SCHED;
            } else {
            PG8_LDB(B0, 0, 0); PG8_SCHED; PG8_LDA(At, 0, 0); PG8_STAGE(PG8_SA(1, 1), a1 + hstep, voffA);
            PG8_WAIT_L(8); PG8_BAR; PG8_WAIT_L(0); PG8_MMA(0, 0, At, B0); PG8_BAR; PG8_SCHED;
            PG8_LDB(B1, 0, 1); PG8_STAGE(PG8_SB(0, 0), b2, voffB);
            PG8_BAR; PG8_WAIT_L(0); PG8_MMA(0, 1, At, B1); PG8_BAR;
            PG8_LDA(At, 0, 1); PG8_STAGE(PG8_SA(0, 0), a2, voffA);
            PG8_BAR; PG8_WAIT_L(0); PG8_MMA(1, 0, At, B0); PG8_BAR; PG8_SCHED;
            PG8_STAGE(PG8_SB(0, 1), b2 + hstep, voffB);
            PG8_WAIT_V(6); PG8_BAR; PG8_MMA(1, 1, At, B1); PG8_BAR;
            PG8_LDB(B0, 1, 0); PG8_SCHED; PG8_LDA(At, 1, 0); PG8_STAGE(PG8_SA(0, 1), a2 + hstep, voffA);
            PG8_WAIT_L(8); PG8_BAR; PG8_WAIT_L(0); PG8_MMA(0, 0, At, B0); PG8_BAR; PG8_SCHED;
            PG8_LDB(B1, 1, 1); PG8_STAGE(PG8_SB(1, 0), b3, voffB);
            PG8_BAR; PG8_WAIT_L(0); PG8_MMA(0, 1, At, B1); PG8_BAR;
            PG8_LDA(At, 1, 1); PG8_STAGE(PG8_SA(1, 0), a3, voffA);
            PG8_BAR; PG8_WAIT_L(0); PG8_MMA(1, 0, At, B0); PG8_BAR; PG8_SCHED;
            PG8_STAGE(PG8_SB(1, 1), b3 + hstep, voffB);
            PG8_WAIT_V(6); PG8_BAR; PG8_MMA(1, 1, At, B1); PG8_BAR;
            }
        }
        if constexpr (ALIGN_EPI) { if (wr == 0) PG8_BAR; }
        if constexpr (!Epi::AFTER_DRAIN) { E(acc, cur, wr, wc, fr, fq); S.done(cur); }
        if (!has_next) break;
#pragma unroll
        for (int a = 0; a < 2; ++a)
#pragma unroll
            for (int b = 0; b < 2; ++b)
#pragma unroll
                for (int m = 0; m < 4; ++m)
#pragma unroll
                    for (int n = 0; n < 2; ++n) acc[a][b][m][n] = (f32x4){0.f, 0.f, 0.f, 0.f};
        cur = nxt; cA = nA; cB = nB; ++ui;
        if constexpr (ALIGN_EPI) { if (wr == 1) PG8_BAR; }
    }
    PG8_WAIT_V(0);
    if constexpr (!ALIGN_EPI) { if (wr == 0) PG8_BAR; }
    PG8_BAR;
    if constexpr (Epi::AFTER_DRAIN) { E.fused(acc, cur, wr, wc, fr, fq, lds, wid, lane); S.done(cur); }
#undef PG8_SA
#undef PG8_SB
#undef PG8_STAGE
#undef PG8_LDA
#undef PG8_LDB
#undef PG8_MMA
#undef PG8_WAIT_V
#undef PG8_WAIT_L
#undef PG8_BAR
#undef PG8_SCHED
}
}

constexpr int NWAVES = 8;
constexpr int S = 8192, D = 4096, NH = 32, HD = 128, DFF = 11008, NQKV = 5 * D, NGU = 2 * DFF;
constexpr float LOG2E = 1.4426950408889634f;
constexpr float QSCALE = 0.08838834764831845f * LOG2E;
constexpr float M2_QK = 11.313708498984761f * LOG2E;
#ifndef MK_PER_PHASE
#define MK_PER_PHASE 1
#endif
constexpr int N_PHASES = 17;

constexpr size_t MiB = 1u << 20;
constexpr size_t WS_CTL = 0, CTL_ZERO_BYTES = 4 * MiB;
constexpr size_t WS_KMEAN = 1 * MiB;
constexpr size_t WS_WQKV = 4 * MiB;
constexpr size_t WS_WOA  = WS_WQKV + 160 * MiB;
constexpr size_t WS_WGU  = WS_WOA + 32 * MiB;
constexpr size_t WS_WDN  = WS_WGU + 344 * MiB;
constexpr size_t WS_WKV  = WS_WDN + 172 * MiB;
constexpr size_t WS_WQB  = WS_WKV + 64 * MiB;
constexpr size_t WS_WOB  = WS_WQB + 32 * MiB;
constexpr size_t WS_HN   = WS_WOB + 32 * MiB;
constexpr size_t WS_HN2  = WS_HN + 64 * MiB;
constexpr size_t WS_PROJ = WS_HN2 + 64 * MiB;
constexpr size_t WS_PART = WS_PROJ + 320 * MiB;
constexpr size_t WS_LPART = WS_PART + 192 * MiB;
constexpr size_t WS_OB   = WS_LPART + 4 * MiB;
constexpr size_t WS_X1   = WS_OB + 64 * MiB;
constexpr size_t WS_X2   = WS_X1 + 128 * MiB;
constexpr size_t WS_HID  = WS_X2 + 128 * MiB;
constexpr size_t WS_SEL  = WS_HID + 172 * MiB;
constexpr size_t WS_END  = WS_SEL + 1 * MiB;
constexpr int CW_TMO = 0, CW_CODE = 1, CW_BAR = 4096;

constexpr int RING_OFF = 0, RING_BYTES = 131072;
constexpr int X_OFF = RING_BYTES, X_BYTES = 8192;
constexpr int LIST_OFF = X_OFF + X_BYTES, LIST_BYTES = 12288;
constexpr int LDSCTL_OFF = LIST_OFF + LIST_BYTES, MISC_OFF = LDSCTL_OFF + 320;
constexpr int LDS_BYTES = LDSCTL_OFF + 512;
#define GAS __attribute__((address_space(1)))
#define LAS __attribute__((address_space(3)))
typedef unsigned short bf16;
typedef unsigned v4u __attribute__((ext_vector_type(4)));
typedef float f32x4 __attribute__((ext_vector_type(4)));
typedef short bf16x8 __attribute__((ext_vector_type(8)));
typedef GAS unsigned gu32;
typedef GAS unsigned long long gu64;
#define RLX_AGENT __ATOMIC_RELAXED, __HIP_MEMORY_SCOPE_AGENT
#define LDS_WAIT() asm volatile("s_waitcnt lgkmcnt(0)" ::: "memory")
#define VM_WAIT() asm volatile("s_waitcnt vmcnt(0)" ::: "memory")
__device__ __forceinline__ unsigned long long rt() { return __builtin_amdgcn_s_memrealtime(); }
__device__ __forceinline__ unsigned f2bf(float f) { unsigned u = __builtin_bit_cast(unsigned, f); return (u + 0x7fffu + ((u >> 16) & 1u)) >> 16; }
__device__ __forceinline__ unsigned pk2(float lo, float hi) { return f2bf(lo) | (f2bf(hi) << 16); }

#define XB_TMO      128
#define XB_XCNT(j)  (256  + 64 * (j))
#define XB_XSUB(j)  (1280 + 64 * (j))
#define XB_XGEN(j)  (2304 + 64 * (j))
#define XB_TOP      3328
#define XB_TOPGEN   3392
#define XCD_BAR_WORDS 3456
#define XB_SPIN_CAP (1u << 18)

__device__ __forceinline__ unsigned xb_ld(unsigned* p)              { return __hip_atomic_load(p, __ATOMIC_RELAXED, __HIP_MEMORY_SCOPE_AGENT); }
__device__ __forceinline__ unsigned xb_add(unsigned* p, unsigned v) { return __hip_atomic_fetch_add(p, v, __ATOMIC_RELAXED, __HIP_MEMORY_SCOPE_AGENT); }
__device__ __forceinline__ unsigned xb_xcc_id() { return (unsigned)__builtin_amdgcn_s_getreg((3 << 11) | 20) & 0xFu; }
#define XB_SPIN(cond, bar) do { unsigned _sp = 0; while (cond) { __builtin_amdgcn_s_sleep(1); \
    if ((++_sp & 255u) == 0u) { if (xb_ld(&(bar)[XB_TMO])) break; if (_sp > XB_SPIN_CAP) { atomicAdd(&(bar)[XB_TMO], 1u); break; } } } } while (0)

struct XcdBarrier {
    unsigned* bar; unsigned x;
    volatile LAS unsigned* st;
};

__device__ __forceinline__ XcdBarrier xcd_barrier_post(unsigned* bar, volatile LAS unsigned* st) {
    XcdBarrier b; b.bar = bar; b.x = xb_xcc_id(); b.st = st;
    if (threadIdx.x == 0) (void)xb_add(&bar[XB_XCNT(b.x)], 1u);
    return b;
}
__device__ __forceinline__ void xcd_barrier_complete(unsigned* bar, unsigned x, unsigned& nloc, unsigned& nx) {
    const unsigned G = gridDim.x * gridDim.y * gridDim.z;
    unsigned sum, cnt, mine, sp = 0u;
    for (;;) {
        sum = 0u; cnt = 0u; mine = 0u;
#pragma unroll
        for (unsigned j = 0; j < 16; ++j) { const unsigned c = xb_ld(&bar[XB_XCNT(j)]); sum += c; cnt += (c > 0u) ? 1u : 0u; mine = (j == x) ? c : mine; }
        if (sum == G) break;
        __builtin_amdgcn_s_sleep(1);
        if ((++sp & 255u) == 0u) { if (xb_ld(&bar[XB_TMO])) break; if (sp > XB_SPIN_CAP) { atomicAdd(&bar[XB_TMO], 1u); break; } }
    }
    nloc = mine > 0u ? mine : 1u; nx = cnt > 0u ? cnt : 1u;
}

__device__ __forceinline__ void xcd_barrier(const XcdBarrier& b) {
    asm volatile("s_waitcnt vmcnt(0)" ::: "memory");
    __syncthreads();
    if (threadIdx.x == 0) {
        unsigned* bar = b.bar;
        __builtin_amdgcn_s_waitcnt(0);
        unsigned nloc = b.st[0], nx = b.st[1];
        if (nloc == 0u) { xcd_barrier_complete(bar, b.x, nloc, nx); b.st[0] = nloc; b.st[1] = nx; }
        const unsigned old = xb_add(&bar[XB_XSUB(b.x)], 1u);
        const unsigned gen = old / nloc;
        if (old + 1u == (gen + 1u) * nloc) {
            __builtin_amdgcn_fence(__ATOMIC_RELEASE, "agent");
            asm volatile("s_waitcnt vmcnt(0)" ::: "memory");
            const unsigned og = xb_add(&bar[XB_TOP], 1u);
            const unsigned tg = og / nx;
            if (og + 1u == (tg + 1u) * nx) xb_add(&bar[XB_TOPGEN], 1u);
            else XB_SPIN(xb_ld(&bar[XB_TOPGEN]) == tg, bar);
            __builtin_amdgcn_fence(__ATOMIC_ACQUIRE, "agent");
            xb_add(&bar[XB_XGEN(b.x)], 1u);
            asm volatile("s_waitcnt vmcnt(0)" ::: "memory");
        } else {
            XB_SPIN(xb_ld(&bar[XB_XGEN(b.x)]) == gen, bar);
            __builtin_amdgcn_fence(__ATOMIC_ACQUIRE, "agent");
            asm volatile("s_waitcnt vmcnt(0)" ::: "memory");
        }
    }
    __syncthreads();
}


typedef short s16x4 __attribute__((ext_vector_type(4)));
typedef float f32x2 __attribute__((ext_vector_type(2)));
typedef __bf16 bf16x2v __attribute__((ext_vector_type(2)));
struct Args { const float* in[16]; float* out; unsigned char* ws; int ph_lo, ph_hi; };
#define KARGS() ((const __attribute__((address_space(4))) Args*)__builtin_amdgcn_kernarg_segment_ptr())
#define INP(k) (KARGS()->in[k])
#define OUTP() (KARGS()->out)
struct Frame {
    LAS unsigned char* lds;
    volatile LAS unsigned* MISC;
    gu32* ctl;
    unsigned char* ws;
    int tid, lane, wave, vcu, G;
};
__device__ __forceinline__ unsigned pkbf(float lo, float hi) { const f32x2 v = {lo, hi}; return __builtin_bit_cast(unsigned, __builtin_convertvector(v, bf16x2v)); }
__device__ __forceinline__ float bflo(unsigned u) { return __builtin_bit_cast(float, u << 16); }
__device__ __forceinline__ float bfhi(unsigned u) { return __builtin_bit_cast(float, u & 0xffff0000u); }
__device__ __forceinline__ float wave_sum(float v) {
#pragma unroll
    for (int o = 1; o < 64; o <<= 1) v += __shfl_xor(v, o);
    return v;
}
__device__ __forceinline__ float wave_max(float v) {
#pragma unroll
    for (int o = 1; o < 64; o <<= 1) v = fmaxf(v, __shfl_xor(v, o));
    return v;
}
__device__ __forceinline__ int t5_bucket(int n) {
    if (n < 16) return n;
    return 16 + (n >= 22) + (n >= 30) + (n >= 40) + (n >= 54) + (n >= 73) + (n >= 99) + (n >= 134) + (n >= 182) + (n >= 246) + (n >= 332) + (n >= 450) + (n >= 609) + (n >= 825) + (n >= 1117) + (n >= 1513);
}
__device__ __forceinline__ float softmax_offset(const Frame& F, const float* gq, int ngq, const float* gk, int ngk) {
    float a = 0.f, b = 0.f, c = 0.f;
    for (int i = F.lane; i < ngq; i += 64) a = fmaxf(a, fabsf(gq[i]));
    for (int i = F.lane; i < ngk; i += 64) b = fmaxf(b, fabsf(gk[i]));
    for (int i = F.lane; i < 1024; i += 64) c = fmaxf(c, fabsf(INP(1)[i]));
    return M2_QK * wave_max(a) * wave_max(b) + LOG2E * wave_max(c);
}

__device__ __forceinline__ void p0_transpose_item(const float* W, int K, int N, bf16* WT, int mode, LAS float* scr, int item, int lane) {
    const int nblk = N / 32, kb = item / nblk, nb = item % nblk, k0 = 64 * kb, n0 = 32 * nb;
#pragma unroll 8
    for (int i = 0; i < 32; ++i) { const int kk = 2 * i + (lane >> 5); scr[kk * 33 + (lane & 31)] = W[(size_t)(k0 + kk) * N + n0 + (lane & 31)]; }
    LDS_WAIT(); asm volatile("" ::: "memory");
    int r0 = n0;
    if (mode == 1) { const int up = n0 >= DFF, j = up ? n0 - DFF : n0; r0 = 256 * (j >> 7) + (up ? 128 : 0) + (j & 127); }
    const int c = lane & 7;
#pragma unroll
    for (int j = 0; j < 4; ++j) { const int n = (lane >> 3) + 8 * j; const LAS float* s = scr + (8 * c) * 33 + n;
        v4u o; o.x = pk2(s[0 * 33], s[1 * 33]); o.y = pk2(s[2 * 33], s[3 * 33]); o.z = pk2(s[4 * 33], s[5 * 33]); o.w = pk2(s[6 * 33], s[7 * 33]);
        *(GAS v4u*)(WT + (size_t)(r0 + n) * K + k0 + 8 * c) = o; }
    LDS_WAIT(); asm volatile("" ::: "memory");
}
__device__ __forceinline__ void rms_rows(Frame& F, const float* X, const float* g1, bf16* out1, const float* g2, bf16* out2) {
    const int gw = F.vcu * NWAVES + F.wave, NGW = F.G * NWAVES;
    for (int m = gw; m < S; m += NGW) {
        const GAS f32x4* xr = (const GAS f32x4*)(X + (size_t)m * D) + F.lane;
        f32x4 v[16]; float s = 0.f;
#pragma unroll
        for (int j = 0; j < 16; ++j) { v[j] = xr[64 * j]; s += (v[j].x * v[j].x + v[j].y * v[j].y) + (v[j].z * v[j].z + v[j].w * v[j].w); }
        const float rstd = 1.0f / sqrtf(wave_sum(s) * (1.0f / D) + 1e-6f);
        GAS unsigned long long* o8 = (GAS unsigned long long*)(out1 + (size_t)m * D) + F.lane;
#pragma unroll
        for (int j = 0; j < 16; ++j) { const f32x4 g = ((const GAS f32x4*)g1)[F.lane + 64 * j]; const f32x4 y = v[j] * rstd * g;
            o8[64 * j] = (unsigned long long)pkbf(y.x, y.y) | ((unsigned long long)pkbf(y.z, y.w) << 32); }
        if (g2 != nullptr) {
            GAS unsigned long long* p8 = (GAS unsigned long long*)(out2 + (size_t)m * D) + F.lane;
#pragma unroll
            for (int j = 0; j < 16; ++j) { const f32x4 g = ((const GAS f32x4*)g2)[F.lane + 64 * j]; const f32x4 y = v[j] * rstd * g;
                p8[64 * j] = (unsigned long long)pkbf(y.x, y.y) | ((unsigned long long)pkbf(y.z, y.w) << 32); }
        }
    }
}
__device__ __forceinline__ void p0_prologue(Frame& F) {
    LAS float* scr = (LAS float*)(F.lds + RING_OFF + F.wave * 16384);
    const int gw = F.vcu * NWAVES + F.wave, NGW = F.G * NWAVES;
    constexpr int I_QKV = (D / 64) * (NQKV / 32), I_DD = (D / 64) * (D / 32), I_GU = (D / 64) * (NGU / 32), I_DN = (DFF / 64) * (D / 32), I_KV = (D / 64) * (2 * D / 32);
    constexpr int NITEMS = I_QKV + 3 * I_DD + 2 * I_GU + 2 * I_DN + I_KV;
    for (int it = gw; it < NITEMS; it += NGW) {
        int r = it;
        if (r < I_QKV) { p0_transpose_item(INP(4), D, NQKV, ((bf16*)(F.ws + (WS_WQKV))), 0, scr, r, F.lane); continue; } r -= I_QKV;
        if (r < I_DD) { p0_transpose_item(INP(7), D, D, ((bf16*)(F.ws + (WS_WOA))), 0, scr, r, F.lane); continue; } r -= I_DD;
        if (r < I_GU) { p0_transpose_item(INP(14), D, NGU, ((bf16*)(F.ws + (WS_WGU))), 1, scr, r, F.lane); continue; } r -= I_GU;
        if (r < I_DN) { p0_transpose_item(INP(15), DFF, D, ((bf16*)(F.ws + (WS_WDN))), 0, scr, r, F.lane); continue; } r -= I_DN;
        if (r < I_KV) { p0_transpose_item(INP(9), D, 2 * D, ((bf16*)(F.ws + (WS_WKV))), 0, scr, r, F.lane); continue; } r -= I_KV;
        if (r < I_DD) { p0_transpose_item(INP(11), D, D, ((bf16*)(F.ws + (WS_WQB))), 0, scr, r, F.lane); continue; } r -= I_DD;
        if (r < I_DD) { p0_transpose_item(INP(13), D, D, ((bf16*)(F.ws + (WS_WOB))), 0, scr, r, F.lane); continue; } r -= I_DD;
        if (r < I_GU) { p0_transpose_item(INP(14) + (size_t)D * NGU, D, NGU, ((bf16*)(F.ws + (WS_WGU))) + (size_t)NGU * D, 1, scr, r, F.lane); continue; } r -= I_GU;
        p0_transpose_item(INP(15) + (size_t)DFF * D, DFF, D, ((bf16*)(F.ws + (WS_WDN))) + (size_t)D * DFF, 0, scr, r, F.lane);
    }
    rms_rows(F, INP(0), INP(2), ((bf16*)(F.ws + (WS_HN))), nullptr, nullptr);
}

constexpr int K_OFF = 0, V_OFF = 65536;
__device__ __forceinline__ unsigned offb(unsigned row, unsigned ch) { return 256u * row + 16u * (ch ^ (((row & 3u) << 2) | ((row >> 2) & 3u))); }
__device__ __forceinline__ void stage_kv(Frame& F, const bf16* kbase, const bf16* vbase, size_t rstride, int first_valid) {
    v4u kr[8], vr[8];
#pragma unroll
    for (int it = 0; it < 8; ++it) { const int idx = F.tid + 512 * it, row = idx >> 4, ch = idx & 15;
        if (row >= first_valid) { kr[it] = *(const GAS v4u*)(kbase + (size_t)row * rstride + ch * 8); vr[it] = *(const GAS v4u*)(vbase + (size_t)row * rstride + ch * 8); }
        else { kr[it] = (v4u){0u, 0u, 0u, 0u}; vr[it] = (v4u){0u, 0u, 0u, 0u}; } }
#pragma unroll
    for (int it = 0; it < 8; ++it) { const int idx = F.tid + 512 * it, row = idx >> 4, ch = idx & 15; const unsigned o = offb(row, ch);
        *(LAS v4u*)(F.lds + K_OFF + o) = kr[it]; *(LAS v4u*)(F.lds + V_OFF + o) = vr[it]; }
}
template <class Term>
__device__ __forceinline__ void attn_pairs(Frame& F, const bf16x8 (&qf)[4], int jp0, int npairs, const Term& term, f32x4 (&o)[8], float& l) {
    const int fr = F.lane & 15, fq = F.lane >> 4;
    const int kp = 8 * (fq & 1) + 4 * (fq >> 1);
    const int pr = 8 * ((fr >> 2) & 1) + 4 * (fr >> 3) + (fr & 3);
    const int tq = fr >> 2, tp = fr & 3;
#pragma unroll 1
    for (int jp = jp0; jp < jp0 + npairs; ++jp) {
        const int ja = 2 * jp, jb = ja + 1;
        f32x4 sa = {0.f, 0.f, 0.f, 0.f}, sb = {0.f, 0.f, 0.f, 0.f};
#pragma unroll
        for (int s = 0; s < 4; ++s) {
            const bf16x8 ka = *(const LAS bf16x8*)(F.lds + K_OFF + offb(16 * ja + pr, 4 * s + fq));
            const bf16x8 kb = *(const LAS bf16x8*)(F.lds + K_OFF + offb(16 * jb + pr, 4 * s + fq));
            sa = __builtin_amdgcn_mfma_f32_16x16x32_bf16(ka, qf[s], sa, 0, 0, 0);
            sb = __builtin_amdgcn_mfma_f32_16x16x32_bf16(kb, qf[s], sb, 0, 0, 0);
        }
        float p[8];
#pragma unroll
        for (int i = 0; i < 4; ++i) { p[i] = term(16 * ja + kp + i, sa[i]); p[4 + i] = term(16 * jb + kp + i, sb[i]); }
        l += ((p[0] + p[1]) + (p[2] + p[3])) + ((p[4] + p[5]) + (p[6] + p[7]));
        v4u pw; pw.x = pkbf(p[0], p[1]); pw.y = pkbf(p[2], p[3]); pw.z = pkbf(p[4], p[5]); pw.w = pkbf(p[6], p[7]);
        const bf16x8 pf = __builtin_bit_cast(bf16x8, pw);
#pragma unroll
        for (int dt = 0; dt < 8; ++dt) {
            const s16x4 va = __builtin_amdgcn_ds_read_tr16_b64_v4i16((LAS s16x4*)(F.lds + V_OFF + offb(16 * ja + kp + tq, 2 * dt + (tp >> 1)) + 8 * (tp & 1)));
            const s16x4 vb = __builtin_amdgcn_ds_read_tr16_b64_v4i16((LAS s16x4*)(F.lds + V_OFF + offb(16 * jb + kp + tq, 2 * dt + (tp >> 1)) + 8 * (tp & 1)));
            const bf16x8 vf = __builtin_shufflevector(va, vb, 0, 1, 2, 3, 4, 5, 6, 7);
            o[dt] = __builtin_amdgcn_mfma_f32_16x16x32_bf16(vf, pf, o[dt], 0, 0, 0);
        }
    }
}
__device__ __forceinline__ void load_qf(const bf16* qrow, int fq, bf16x8 (&qf)[4]) {
#pragma unroll
    for (int s = 0; s < 4; ++s) qf[s] = *(const GAS bf16x8*)(qrow + 32 * s + 8 * fq);
}

__device__ __forceinline__ void p_dilated(Frame& F) {
    const float M2 = softmax_offset(F, INP(5), 3 * HD, INP(6), HD);
    LAS float* lut = (LAS float*)(F.lds + X_OFF);
    const int fr = F.lane & 15, fq = F.lane >> 4, w = F.wave;
    for (int u = F.vcu; u < NH * 3 * 64; u += F.G) {
        const int h = u / 192, g = (u % 192) / 64, rb = u % 64;
        const int dsh = 2 * g, d = 1 << dsh, nb = 64 >> dsh, r = rb / nb, b = rb % nb;
        const long tk0 = ((long)(128 * (b - 1)) << dsh) + r;
        stage_kv(F, ((bf16*)(F.ws + (WS_PROJ))) + tk0 * NQKV + 3 * D + h * HD, ((bf16*)(F.ws + (WS_PROJ))) + tk0 * NQKV + 4 * D + h * HD, (size_t)NQKV << dsh, b == 0 ? 128 : 0);
        if (F.tid <= 128) lut[F.tid] = INP(1)[t5_bucket(F.tid << dsh) * NH + h] * LOG2E - M2;
        __syncthreads();
        const int iq = 16 * w + fr;
        const long tq = ((long)(128 * b + iq) << dsh) + r;
        bf16x8 qf[4]; load_qf(((bf16*)(F.ws + (WS_PROJ))) + tq * NQKV + g * D + h * HD, fq, qf);
        f32x4 o[8];
#pragma unroll
        for (int dt = 0; dt < 8; ++dt) o[dt] = (f32x4){0.f, 0.f, 0.f, 0.f};
        float l = 0.f;
        const int kmin = (b == 0) ? 128 : 0;
        auto term = [&](int key, float s) -> float { const int dist = 128 + iq - key; const bool ok = (dist >= 0) && (dist <= 128) && (key >= kmin);
            const float lv = lut[ok ? dist : 0]; return ok ? __builtin_amdgcn_exp2f(s + lv) : 0.f; };
        attn_pairs(F, qf, w >> 1, 5, term, o, l);
        l += __shfl_xor(l, 16); l += __shfl_xor(l, 32);
        bf16* po = ((bf16*)(F.ws + (WS_PART))) + (size_t)g * S * D + (size_t)tq * D + h * HD + 4 * fq;
#pragma unroll
        for (int dt = 0; dt < 8; ++dt) *(GAS unsigned long long*)(po + 16 * dt) = (unsigned long long)pkbf(o[dt][0], o[dt][1]) | ((unsigned long long)pkbf(o[dt][2], o[dt][3]) << 32);
        if (fq == 0) ((float*)(F.ws + (WS_LPART)))[(size_t)g * S * NH + (size_t)tq * NH + h] = l;
        __syncthreads();
    }
}
__device__ __forceinline__ void p_merge3(Frame& F) {
    const size_t n8 = (size_t)S * D / 8;
    for (size_t i = (size_t)F.vcu * 512 + F.tid; i < n8; i += (size_t)F.G * 512) {
        const size_t t = i / (D / 8); const int c8 = (int)(i % (D / 8)), h = c8 / (HD / 8);
        const float L = ((float*)(F.ws + (WS_LPART)))[t * NH + h] + ((float*)(F.ws + (WS_LPART)))[(size_t)S * NH + t * NH + h] + ((float*)(F.ws + (WS_LPART)))[(size_t)2 * S * NH + t * NH + h];
        const float inv = 1.0f / L;
        const v4u a = *(const GAS v4u*)(((bf16*)(F.ws + (WS_PART))) + i * 8), b = *(const GAS v4u*)(((bf16*)(F.ws + (WS_PART))) + (size_t)S * D + i * 8), c = *(const GAS v4u*)(((bf16*)(F.ws + (WS_PART))) + (size_t)2 * S * D + i * 8);
        v4u o;
        o.x = pkbf((bflo(a.x) + bflo(b.x) + bflo(c.x)) * inv, (bfhi(a.x) + bfhi(b.x) + bfhi(c.x)) * inv);
        o.y = pkbf((bflo(a.y) + bflo(b.y) + bflo(c.y)) * inv, (bfhi(a.y) + bfhi(b.y) + bfhi(c.y)) * inv);
        o.z = pkbf((bflo(a.z) + bflo(b.z) + bflo(c.z)) * inv, (bfhi(a.z) + bfhi(b.z) + bfhi(c.z)) * inv);
        o.w = pkbf((bflo(a.w) + bflo(b.w) + bflo(c.w)) * inv, (bfhi(a.w) + bfhi(b.w) + bfhi(c.w)) * inv);
        *(GAS v4u*)(((bf16*)(F.ws + (WS_OB))) + i * 8) = o;
    }
}
__device__ __forceinline__ void p_gate(Frame& F) {
    LAS float* km = (LAS float*)(F.lds + RING_OFF);
    for (int u = F.vcu; u < 32 * 16; u += F.G) {
        const int c = u / 16, hp = u % 16;
        for (int i = F.tid; i < c * 256; i += 512) km[i] = ((float*)(F.ws + (WS_KMEAN)))[(size_t)(i >> 8) * D + hp * 256 + (i & 255)];
        __syncthreads();
        const int hh = F.tid >> 8, head = 2 * hp + hh, t = 256 * c + (F.tid & 255);
        v4u q[16];
        const GAS v4u* qp = (const GAS v4u*)(((bf16*)(F.ws + (WS_PROJ))) + (size_t)t * D + head * HD);
#pragma unroll
        for (int k = 0; k < 16; ++k) q[k] = qp[k];
        float v0 = -3.0e38f, v1 = -3.0e38f, v2 = -3.0e38f; unsigned i0 = 0xffu, i1 = 0xffu, i2 = 0xffu;
        for (int n = 0; n < c; ++n) {
            const LAS f32x4* kr = (const LAS f32x4*)(km + (n * 2 + hh) * 128);
            float dot = 0.f;
#pragma unroll
            for (int k = 0; k < 16; ++k) { const f32x4 ka = kr[2 * k], kb = kr[2 * k + 1];
                dot += (bflo(q[k].x) * ka.x + bfhi(q[k].x) * ka.y) + (bflo(q[k].y) * ka.z + bfhi(q[k].y) * ka.w) + (bflo(q[k].z) * kb.x + bfhi(q[k].z) * kb.y) + (bflo(q[k].w) * kb.z + bfhi(q[k].w) * kb.w); }
            if (dot > v0) { v2 = v1; i2 = i1; v1 = v0; i1 = i0; v0 = dot; i0 = (unsigned)n; }
            else if (dot > v1) { v2 = v1; i2 = i1; v1 = dot; i1 = (unsigned)n; }
            else if (dot > v2) { v2 = dot; i2 = (unsigned)n; }
        }
        ((unsigned*)(F.ws + (WS_SEL)))[(size_t)head * S + t] = i0 | (i1 << 8) | (i2 << 16) | 0xff000000u;
        __syncthreads();
    }
}
__constant__ unsigned char PB_ITEMS[78][3] = {{16,17,29},{0,6,10},{1,6,10},{2,6,10},{3,6,10},{5,6,10},{4,13,22},{7,13,22},{12,13,22},{0,16,27},{1,16,27},{2,16,27},{3,16,27},{5,16,27},{9,16,27},{15,16,27},{8,9,15},{11,12,20},{8,15,25},{14,15,25},{6,18,30},{10,18,30},{17,18,30},{13,14,23},{6,11,18},{10,11,18},{4,8,13},{7,8,13},{4,5,8},{18,19,31},{0,10,16},{1,10,16},{2,10,16},{3,10,16},{5,10,16},{9,10,16},{11,20,32},{19,20,32},{6,7,11},{0,4,6},{1,4,6},{2,4,6},{3,4,6},{20,21,32},{4,22,32},{7,22,32},{12,22,32},{21,22,32},{13,23,32},{22,23,32},{0,1,2},{0,2,3},{0,3,4},{1,2,3},{1,3,4},{2,3,4},{23,24,32},{8,25,32},{14,25,32},{24,25,32},{25,26,32},{0,27,32},{1,27,32},{2,27,32},{3,27,32},{5,27,32},{9,27,32},{15,27,32},{26,27,32},{27,28,32},{16,29,32},{28,29,32},{6,30,32},{10,30,32},{17,30,32},{29,30,32},{18,31,32},{30,31,32}};
constexpr int N_PB = 78;
__device__ __forceinline__ void build_lut_moba(Frame& F, int h, float M2, int n) {
    LAS float* lut = (LAS float*)(F.lds + X_OFF);
    for (int i = F.tid; i < n; i += 512) lut[i] = INP(1)[t5_bucket(i) * NH + h] * LOG2E - M2;
}
__device__ __forceinline__ void p_past(Frame& F) {
    const float M2 = softmax_offset(F, INP(12), HD, INP(10), HD);
    LAS float* lut = (LAS float*)(F.lds + X_OFF);
    LAS unsigned* list = (LAS unsigned*)(F.lds + LIST_OFF);
    LAS unsigned* cntp = (LAS unsigned*)(F.lds + LDSCTL_OFF);
    const int fr = F.lane & 15, fq = F.lane >> 4;
    for (int it = F.vcu; it < N_PB * NH; it += F.G) {
        const int k = it / NH, h = it % NH;
        const int n = PB_ITEMS[k][0], c_lo = PB_ITEMS[k][1], c_hi = PB_ITEMS[k][2];
        if (F.tid == 0) *cntp = 0u;
        stage_kv(F, ((bf16*)(F.ws + (WS_PROJ + 64 * MiB))) + (size_t)(256 * n) * (2 * D) + h * HD, ((bf16*)(F.ws + (WS_PROJ + 64 * MiB))) + (size_t)(256 * n) * (2 * D) + D + h * HD, (size_t)(2 * D), 0);
        build_lut_moba(F, h, M2, 2048);
        __syncthreads();
        const int ncand = 256 * (c_hi - c_lo);
        for (int i = F.tid; i < ncand; i += 512) {
            const int t = 256 * c_lo + i; const unsigned s = ((unsigned*)(F.ws + (WS_SEL)))[(size_t)h * S + t];
            const int slot = ((s & 0xffu) == (unsigned)n) ? 0 : ((((s >> 8) & 0xffu) == (unsigned)n) ? 1 : ((((s >> 16) & 0xffu) == (unsigned)n) ? 2 : -1));
            const unsigned long long mask = __ballot(slot >= 0);
            unsigned base = 0u;
            if (F.lane == 0 && mask != 0ull) base = atomicAdd((unsigned*)cntp, (unsigned)__popcll(mask));
            base = (unsigned)__builtin_amdgcn_readfirstlane((int)base);
            if (slot >= 0) list[base + (unsigned)__popcll(mask & ((1ull << F.lane) - 1ull))] = (unsigned)t | ((unsigned)slot << 16);
        }
        __syncthreads();
        const int cnt = (int)*cntp, ntile = (cnt + 15) >> 4;
        for (int ti = F.wave; ti < ntile; ti += NWAVES) {
            const int e = 16 * ti + fr; const bool valid = e < cnt;
            const unsigned ent = list[valid ? e : 0];
            const int t = (int)(ent & 0xffffu), slot = (int)(ent >> 16);
            bf16x8 qf[4]; load_qf(((bf16*)(F.ws + (WS_PROJ))) + (size_t)t * D + h * HD, fq, qf);
            f32x4 o[8];
#pragma unroll
            for (int dt = 0; dt < 8; ++dt) o[dt] = (f32x4){0.f, 0.f, 0.f, 0.f};
            float l = 0.f;
            const int tbase = t - 256 * n;
            auto term = [&](int key, float s) -> float { const int dist = tbase - key; return __builtin_amdgcn_exp2f(s + lut[dist < 2047 ? dist : 2047]); };
            attn_pairs(F, qf, 0, 8, term, o, l);
            l += __shfl_xor(l, 16); l += __shfl_xor(l, 32);
            if (valid) {
                bf16* po = ((bf16*)(F.ws + (WS_PART))) + (size_t)slot * S * D + (size_t)t * D + h * HD + 4 * fq;
#pragma unroll
                for (int dt = 0; dt < 8; ++dt) *(GAS unsigned long long*)(po + 16 * dt) = (unsigned long long)pkbf(o[dt][0], o[dt][1]) | ((unsigned long long)pkbf(o[dt][2], o[dt][3]) << 32);
                if (fq == 0) ((float*)(F.ws + (WS_LPART)))[(size_t)slot * S * NH + (size_t)t * NH + h] = l;
            }
        }
        __syncthreads();
    }
}
__device__ __forceinline__ void p_own(Frame& F) {
    const float M2 = softmax_offset(F, INP(12), HD, INP(10), HD);
    LAS float* lut = (LAS float*)(F.lds + X_OFF);
    const int fr = F.lane & 15, fq = F.lane >> 4, w = F.wave;
    for (int u = F.vcu; u < 32 * NH; u += F.G) {
        const int c = u / NH, h = u % NH;
        stage_kv(F, ((bf16*)(F.ws + (WS_PROJ + 64 * MiB))) + (size_t)(256 * c) * (2 * D) + h * HD, ((bf16*)(F.ws + (WS_PROJ + 64 * MiB))) + (size_t)(256 * c) * (2 * D) + D + h * HD, (size_t)(2 * D), 0);
        build_lut_moba(F, h, M2, 256);
        __syncthreads();
        const int nslot = c < 3 ? c : 3;
#pragma unroll 1
        for (int pass = 0; pass < 2; ++pass) {
            const int qt = pass == 0 ? w : 15 - w, iq = 16 * qt + fr, t = 256 * c + iq;
            bf16x8 qf[4]; load_qf(((bf16*)(F.ws + (WS_PROJ))) + (size_t)t * D + h * HD, fq, qf);
            f32x4 o[8];
#pragma unroll
            for (int dt = 0; dt < 8; ++dt) o[dt] = (f32x4){0.f, 0.f, 0.f, 0.f};
            float l = 0.f;
            auto term = [&](int key, float s) -> float { const int dist = iq - key; const bool ok = dist >= 0; const float lv = lut[ok ? dist : 0]; return ok ? __builtin_amdgcn_exp2f(s + lv) : 0.f; };
            attn_pairs(F, qf, 0, (qt >> 1) + 1, term, o, l);
            l += __shfl_xor(l, 16); l += __shfl_xor(l, 32);
            for (int s = 0; s < nslot; ++s) {
                l += ((float*)(F.ws + (WS_LPART)))[(size_t)s * S * NH + (size_t)t * NH + h];
                const bf16* pp = ((bf16*)(F.ws + (WS_PART))) + (size_t)s * S * D + (size_t)t * D + h * HD + 4 * fq;
#pragma unroll
                for (int dt = 0; dt < 8; ++dt) { const unsigned long long v = *(const GAS unsigned long long*)(pp + 16 * dt); const unsigned lo = (unsigned)v, hi = (unsigned)(v >> 32);
                    o[dt][0] += bflo(lo); o[dt][1] += bfhi(lo); o[dt][2] += bflo(hi); o[dt][3] += bfhi(hi); }
            }
            const float inv = 1.0f / l;
            bf16* po = ((bf16*)(F.ws + (WS_OB))) + (size_t)t * D + h * HD + 4 * fq;
#pragma unroll
            for (int dt = 0; dt < 8; ++dt) *(GAS unsigned long long*)(po + 16 * dt) = (unsigned long long)pkbf(o[dt][0] * inv, o[dt][1] * inv) | ((unsigned long long)pkbf(o[dt][2] * inv, o[dt][3] * inv) << 32);
        }
        __syncthreads();
    }
}
#ifndef EN_P0
#define EN_P0 1
#endif
#ifndef EN_P1
#define EN_P1 1
#endif
#ifndef EN_P2
#define EN_P2 1
#endif
#ifndef EN_P3
#define EN_P3 1
#endif
#ifndef EN_P8
#define EN_P8 1
#endif
#ifndef EN_P9
#define EN_P9 1
#endif
#ifndef EN_P10
#define EN_P10 1
#endif
#ifndef EN_P11
#define EN_P11 1
#endif
#ifndef EN_P12
#define EN_P12 1
#endif
#ifndef EN_PWO
#define EN_PWO 1
#endif
#ifndef EN_PN
#define EN_PN 1
#endif
#ifndef EN_PGU
#define EN_PGU 1
#endif
#ifndef EN_PDN
#define EN_PDN 1
#endif

template <int PH_LO, int PH_HI>
__global__ void __launch_bounds__(NWAVES * 64, 2) yoco_fwd(Args args) {
    extern __shared__ __attribute__((aligned(16))) unsigned char lds[];
    Frame F;
    F.lds = (LAS unsigned char*)lds;
    F.MISC = (volatile LAS unsigned*)(F.lds + MISC_OFF);
    F.tid = threadIdx.x; F.lane = F.tid & 63; F.wave = __builtin_amdgcn_readfirstlane(F.tid >> 6);
    F.G = gridDim.x; { const int bx = blockIdx.x; F.vcu = (F.G % 8 == 0) ? (bx % 8) * (F.G / 8) + bx / 8 : bx; }
    unsigned char* ws = args.ws; F.ws = ws;
    F.ctl = (gu32*)(ws + WS_CTL);
    for (int u = F.tid; u < (LDS_BYTES - LDSCTL_OFF) / 4; u += NWAVES * 64) ((LAS unsigned*)(F.lds + LDSCTL_OFF))[u] = 0u;
    __syncthreads();
    XcdBarrier bar; bar.bar = (unsigned*)(F.ctl + CW_BAR); bar.x = 0; bar.st = nullptr;
    if (PH_HI - PH_LO > 1) bar = xcd_barrier_post((unsigned*)(F.ctl + CW_BAR), F.MISC + 8);
#define GRID_BAR() do { if (PH_HI - PH_LO > 1) xcd_barrier(bar); } while (0)
    constexpr int lo = PH_LO, hi = PH_HI;
#define IN(k) (lo <= (k) && (k) < hi)
#define SEAM(k) do { if (IN(k) && IN((k) + 1)) GRID_BAR(); } while (0)
    LAS unsigned char* ring = F.lds + RING_OFF;
    LAS float* xch = (LAS float*)(F.lds + X_OFF);

    if (EN_P0 && IN(0)) { p0_prologue(F); } SEAM(0);

    {
            if (EN_P1 && IN(1)) { pg8::Gemm g{((bf16*)(F.ws + (WS_HN))), ((bf16*)(F.ws + (WS_WQKV))), S, NQKV, D}; pg8::StaticOrder So; So.init(S, NQKV, F.G, (int)blockIdx.x);
                pg8::EpiHeadNorm E{((bf16*)(F.ws + (WS_PROJ))), NQKV, 48, 4, 16, INP(5), INP(6), QSCALE, nullptr, xch};
                pg8::gemm_phase<pg8::EpiHeadNorm, pg8::StaticOrder, true, true>(ring, g, So, E); } SEAM(1);
            if (EN_P2 && IN(2)) { p_dilated(F); } SEAM(2);
            if (EN_P3 && IN(3)) { p_merge3(F); } SEAM(3);
    }
#define LAYER_TAIL(l) {        const int pb = l ? 13 : 4; \
        const float* xin = l ? ((float*)(F.ws + (WS_X2))) : INP(0); \
        if (EN_PWO && IN(pb)) { pg8::Gemm g{((bf16*)(F.ws + (WS_OB))), l ? ((bf16*)(F.ws + (WS_WOB))) : ((bf16*)(F.ws + (WS_WOA))), S, D, D}; pg8::StaticOrder So; So.init(S, D, F.G, (int)blockIdx.x); \
            pg8::EpiResF32 E{xin, ((float*)(F.ws + (WS_X1))), D}; \
            pg8::gemm_phase<pg8::EpiResF32, pg8::StaticOrder, true, true>(ring, g, So, E); } SEAM(pb); \
        if (EN_PN && IN(pb + 1)) { rms_rows(F, ((float*)(F.ws + (WS_X1))), INP(3) + l * D, ((bf16*)(F.ws + (WS_HN))), nullptr, nullptr); } SEAM(pb + 1); \
        if (EN_PGU && IN(pb + 2)) { pg8::Gemm g{((bf16*)(F.ws + (WS_HN))), ((bf16*)(F.ws + (WS_WGU))) + (size_t)l * NGU * D, S, NGU, D}; pg8::StaticOrder So; So.init(S, NGU, F.G, (int)blockIdx.x); \
            pg8::EpiSwiGLU E{((bf16*)(F.ws + (WS_HID))), DFF}; \
            pg8::gemm_phase<pg8::EpiSwiGLU, pg8::StaticOrder, true, true>(ring, g, So, E); } SEAM(pb + 2); \
        if (EN_PDN && IN(pb + 3)) { pg8::Gemm g{((bf16*)(F.ws + (WS_HID))), ((bf16*)(F.ws + (WS_WDN))) + (size_t)l * D * DFF, S, D, DFF}; pg8::StaticOrder So; So.init(S, D, F.G, (int)blockIdx.x); \
            pg8::EpiResF32 E{((float*)(F.ws + (WS_X1))), l ? OUTP() : ((float*)(F.ws + (WS_X2))), D}; \
            pg8::gemm_phase<pg8::EpiResF32, pg8::StaticOrder, true, true>(ring, g, So, E); } }
    LAYER_TAIL(0)
    SEAM(7);
    {
            if (EN_P8 && IN(8)) { rms_rows(F, ((float*)(F.ws + (WS_X2))), INP(8), ((bf16*)(F.ws + (WS_HN))), INP(2) + D, ((bf16*)(F.ws + (WS_HN2)))); } SEAM(8);
            if (EN_P9 && IN(9)) {
                { pg8::Gemm g{((bf16*)(F.ws + (WS_HN))), ((bf16*)(F.ws + (WS_WKV))), S, 2 * D, D}; pg8::StaticOrder So; So.init(S, 2 * D, F.G, (int)blockIdx.x);
                  pg8::EpiHeadNorm E{((bf16*)(F.ws + (WS_PROJ + 64 * MiB))), 2 * D, 0, 31, 16, INP(12), INP(10), QSCALE, ((float*)(F.ws + (WS_KMEAN))), xch};
                  pg8::gemm_phase<pg8::EpiHeadNorm, pg8::StaticOrder, true, true>(ring, g, So, E); }
                { pg8::Gemm g{((bf16*)(F.ws + (WS_HN2))), ((bf16*)(F.ws + (WS_WQB))), S, D, D}; pg8::StaticOrder So; So.init(S, D, F.G, (int)blockIdx.x);
                  pg8::EpiHeadNorm E{((bf16*)(F.ws + (WS_PROJ))), D, 16, 31, 0, INP(12), INP(10), QSCALE, nullptr, xch};
                  pg8::gemm_phase<pg8::EpiHeadNorm, pg8::StaticOrder, true, true>(ring, g, So, E); }
            } SEAM(9);
            if (EN_P10 && IN(10)) { p_gate(F); } SEAM(10);
            if (EN_P11 && IN(11)) { p_past(F); } SEAM(11);
            if (EN_P12 && IN(12)) { p_own(F); } SEAM(12);
            }
    LAYER_TAIL(1)
#undef LAYER_TAIL
#undef IN
#undef SEAM
#undef GRID_BAR
}

extern "C" void kernel_launch(void* const* d_in, const int* in_sizes, int n_in, void* d_out, int out_size, void* d_ws, size_t ws_size, hipStream_t stream) {
    static int grid = 0;
    if (grid == 0) {
        if (n_in != 16 || in_sizes[0] != S * D || out_size != S * D || ws_size < WS_END) { fprintf(stderr, "kernel_launch: shape/workspace mismatch: n_in %d in0 %d out %d ws %zu (need %zu)\n", n_in, n_in > 0 ? in_sizes[0] : -1, out_size, ws_size, (size_t)WS_END); grid = -1; return; }
        int dev = 0, cus = 0, per_cu = 0;
        if (hipGetDevice(&dev) != hipSuccess || hipDeviceGetAttribute(&cus, hipDeviceAttributeMultiprocessorCount, dev) != hipSuccess) { fprintf(stderr, "kernel_launch: device query failed\n"); grid = -1; return; }
#if MK_PER_PHASE
        hipError_t fe = hipSuccess;
#define SETATTR(P) if (fe == hipSuccess) fe = hipFuncSetAttribute((const void*)yoco_fwd<P, P + 1>, hipFuncAttributeMaxDynamicSharedMemorySize, LDS_BYTES);
        SETATTR(0) SETATTR(1) SETATTR(2) SETATTR(3) SETATTR(4) SETATTR(5) SETATTR(6) SETATTR(7) SETATTR(8) SETATTR(9) SETATTR(10) SETATTR(11) SETATTR(12) SETATTR(13) SETATTR(14) SETATTR(15) SETATTR(16)
#undef SETATTR
        if (fe != hipSuccess) { fprintf(stderr, "kernel_launch: hipFuncSetAttribute failed\n"); grid = -1; return; }
#else
        if (hipFuncSetAttribute((const void*)yoco_fwd<0, N_PHASES>, hipFuncAttributeMaxDynamicSharedMemorySize, LDS_BYTES) != hipSuccess) { fprintf(stderr, "kernel_launch: hipFuncSetAttribute failed\n"); grid = -1; return; }
        if (hipOccupancyMaxActiveBlocksPerMultiprocessor(&per_cu, (const void*)yoco_fwd<0, N_PHASES>, NWAVES * 64, LDS_BYTES) != hipSuccess || per_cu < 1)
            fprintf(stderr, "kernel_launch: note: occupancy query reports %d workgroups per CU\n", per_cu);
#endif
        (void)hipGetLastError();
        grid = cus;
    }
    if (grid < 0) return;
    if (hipMemsetAsync((char*)d_ws + WS_CTL, 0, CTL_ZERO_BYTES, stream) != hipSuccess) { fprintf(stderr, "kernel_launch: memset failed\n"); return; }
    Args a{};
    for (int i = 0; i < 16; ++i) a.in[i] = (const float*)d_in[i];
    a.out = (float*)d_out; a.ws = (unsigned char*)d_ws;
#if MK_PER_PHASE
#define LAUNCH(P) hipLaunchKernelGGL((yoco_fwd<P, P + 1>), dim3(grid), dim3(NWAVES * 64), LDS_BYTES, stream, a);
    LAUNCH(0) LAUNCH(1) LAUNCH(2) LAUNCH(3) LAUNCH(4) LAUNCH(5) LAUNCH(6) LAUNCH(7) LAUNCH(8) LAUNCH(9) LAUNCH(10) LAUNCH(11) LAUNCH(12) LAUNCH(13) LAUNCH(14) LAUNCH(15) LAUNCH(16)
#undef LAUNCH
#else
    hipLaunchKernelGGL((yoco_fwd<0, N_PHASES>), dim3(grid), dim3(NWAVES * 64), LDS_BYTES, stream, a);
#endif
    const hipError_t le = hipPeekAtLastError();
    if (le != hipSuccess) fprintf(stderr, "kernel_launch: launch failed: %s\n", hipGetErrorName(le));
}
```

```cpp
#include <hip/hip_runtime.h>
#include <cstdio>
#include <cstdint>
template <int M> __device__ __forceinline__ int xshf_i(int v) {
    if constexpr (M < 32) return __builtin_amdgcn_ds_swizzle(v, (M << 10) | 0x1f);
    else { const auto r = __builtin_amdgcn_permlane32_swap(v, v, false, false); return (int)((__builtin_amdgcn_mbcnt_hi(~0u, __builtin_amdgcn_mbcnt_lo(~0u, 0u)) < 32u) ? r[1] : r[0]); }
}
template <int M> __device__ __forceinline__ float xshf(float v) { return __builtin_bit_cast(float, xshf_i<M>(__builtin_bit_cast(int, v))); }
namespace pg8 {
#define PG8_LAS __attribute__((address_space(3)))
typedef unsigned short bf16_t;
typedef short bf16x8 __attribute__((ext_vector_type(8)));
typedef float f32x4 __attribute__((ext_vector_type(4)));
typedef unsigned u32x4 __attribute__((ext_vector_type(4)));
constexpr int BM = 256, BK = 64, HALF = 128, HTB = HALF * BK * 2  , STAGE_BYTES = 8 * HTB, NXCD = 8, WGM = 8;

__host__ __device__ __forceinline__ int lds_byte(int r, int c) { const int st = (r >> 4) * 2 + (c >> 5), rr = r & 15, cc = c & 31, ob = rr * 64 + cc * 2; return st * 1024 + (ob ^ (((ob >> 9) & 1) << 5)); }
__host__ __device__ __forceinline__ void stage_rc(int b, int& R, int& C) { const int st = b / 1024, sb = b % 1024, swz = sb ^ (((sb >> 9) & 1) << 5); R = (st >> 1) * 16 + swz / 64; C = (st & 1) * 32 + (swz % 64) / 2; }
__host__ __device__ __forceinline__ int perm32(int rho) { const int n = rho >> 4, i = rho & 15; return 8 * (i >> 2) + 4 * n + (i & 3); }

struct Unit { int pm, pn; };
struct Gemm { const bf16_t* A; const bf16_t* Bt; int M, N, K; };

struct StaticOrder {
    int nM, nN, nwg, G, c;
    __host__ __device__ void init(int M, int N, int G_, int c_) { nM = M / BM; nN = N / BM; nwg = nM * nN; G = G_; c = c_; }
    __host__ __device__ bool next(int i, Unit& u) const {
        const long L = (long)i * G + c; if (L >= nwg) return false;
        int wgid = (int)L; { const int q = nwg / NXCD, r = nwg % NXCD, xcd = wgid % NXCD, off = wgid / NXCD; wgid = (xcd < r ? xcd * (q + 1) : r * (q + 1) + (xcd - r) * q) + off; }
        const int nig = WGM * nN, gid = wgid / nig, fm = gid * WGM, gsz = (nM - fm) < WGM ? (nM - fm) : WGM;
        u.pm = fm + ((wgid % nig) % gsz); u.pn = (wgid % nig) / gsz; return true;
    }
    __device__ __forceinline__ void a_ready(const Unit&) const {}
    __device__ __forceinline__ void done(const Unit&) const {}
};

struct RangeOrder : StaticOrder {
    int i0, i1;
    __host__ __device__ bool next(int i, Unit& u) const { return (i0 + i < i1) && StaticOrder::next(i0 + i, u); }
};

__device__ __forceinline__ unsigned cvt_pk_bf16(float lo, float hi) { unsigned r; asm volatile("v_cvt_pk_bf16_f32 %0, %1, %2" : "=v"(r) : "v"(lo), "v"(hi)); return r; }
typedef float f32x2 __attribute__((ext_vector_type(2)));

constexpr float RMS_EPS = 1e-6f;

#ifndef STORE_POLICY
#define STORE_POLICY 0
#endif
__device__ __forceinline__ void st16(void* p, u32x4 v) {
#if STORE_POLICY == 1
    asm volatile("global_store_dwordx4 %0, %1, off sc1" :: "v"(p), "v"(v) : "memory");
#elif STORE_POLICY == 2
    __builtin_nontemporal_store(v, (u32x4*)p);
#else
    *(u32x4*)p = v;
#endif
}
__device__ __forceinline__ void st16f(void* p, f32x4 v) { st16(p, __builtin_bit_cast(u32x4, v)); }

__device__ __forceinline__ void rstd_panel(PG8_LAS float* rt, const float* pss, int pm, int tid) {
    if (__builtin_amdgcn_readfirstlane(__float_as_int(rt[0])) != pm) {
        asm volatile("s_waitcnt lgkmcnt(0)" ::: "memory"); __builtin_amdgcn_s_barrier(); asm volatile("" ::: "memory");
        if (tid < BM) { const f32x4* p = (const f32x4*)(pss + (size_t)(pm * BM + tid) * 16);
            const f32x4 a = p[0], b = p[1], c = p[2], d = p[3];
            const float s = (((a[0] + a[1]) + (a[2] + a[3])) + ((b[0] + b[1]) + (b[2] + b[3]))) + (((c[0] + c[1]) + (c[2] + c[3])) + ((d[0] + d[1]) + (d[2] + d[3])));
            rt[1 + tid] = __builtin_amdgcn_rsqf(s * (1.0f / 4096.0f) + RMS_EPS); }
        if (tid == 0) rt[0] = __int_as_float(pm);
        asm volatile("s_waitcnt lgkmcnt(0)" ::: "memory"); __builtin_amdgcn_s_barrier(); asm volatile("" ::: "memory");
    }
}
struct EpiHeadNorm {
    static constexpr bool PERM = true, AFTER_DRAIN = false, INIT_BASE = false;
    bf16_t* O; int ldc; int q0, n_q, q_shift, k0, n_k; const float* gq; const float* gk; float qscale; float* kmean; PG8_LAS float* X; const float* pss; PG8_LAS float* rt;
    __device__ __forceinline__ void operator()(const f32x4 (&acc0)[2][2][4][2], const Unit& u, int wr, int wc, int fr, int fq) const {
        const int pn = u.pn, row0 = u.pm * BM + wr * 64 + fr;
        const bool isq = (pn >= q0) && (pn < q0 + n_q), isk = (pn >= k0) && (pn < k0 + n_k);
        bf16_t* Ob = O + (size_t)(2 * pn) * ldc * 128 + wc * 32 + 8 * fq; const size_t hstr = (size_t)ldc * 128;
        rstd_panel(rt, pss, u.pm, (wr * 4 + wc) * 64 + fq * 16 + fr);
        f32x4 acc[2][2][4][2];
#pragma unroll
        for (int ai = 0; ai < 2; ++ai)
#pragma unroll
            for (int m = 0; m < 4; ++m) { const float rr = rt[1 + ai * HALF + wr * 64 + m * 16 + fr];
#pragma unroll
                for (int bj = 0; bj < 2; ++bj) { acc[ai][bj][m][0] = acc0[ai][bj][m][0] * rr; acc[ai][bj][m][1] = acc0[ai][bj][m][1] * rr; } }
        if (!isq && !isk) {
#pragma unroll
            for (int ai = 0; ai < 2; ++ai)
#pragma unroll
                for (int m = 0; m < 4; ++m) { bf16_t* rowp = Ob + (size_t)(row0 + ai * HALF + m * 16) * 128;
#pragma unroll
                    for (int bj = 0; bj < 2; ++bj) { const f32x4 v0 = acc[ai][bj][m][0], v1 = acc[ai][bj][m][1];
                        u32x4 w; w.x = cvt_pk_bf16(v0[0], v0[1]); w.y = cvt_pk_bf16(v0[2], v0[3]); w.z = cvt_pk_bf16(v1[0], v1[1]); w.w = cvt_pk_bf16(v1[2], v1[3]);
                        st16(rowp + bj * hstr, w); } }
            return;
        }
        const float* g = isq ? gq + ((pn - q0) >> q_shift) * 128 : gk;
        const float sc = isq ? qscale : 1.f;
#pragma unroll
        for (int ai = 0; ai < 2; ++ai)
#pragma unroll
            for (int bj = 0; bj < 2; ++bj)
#pragma unroll
                for (int m = 0; m < 4; ++m) { const f32x4 a = acc[ai][bj][m][0], b = acc[ai][bj][m][1];
                    const f32x4 q4 = a * a + b * b;
                    float s = (q4[0] + q4[1]) + (q4[2] + q4[3]);
                    s += xshf<16>(s); s += xshf<32>(s);
                    if (fq == 0) X[((ai * HALF + wr * 64 + m * 16 + fr) * 2 + bj) * 4 + wc] = s; }
        asm volatile("s_waitcnt lgkmcnt(0)" ::: "memory"); __builtin_amdgcn_s_barrier(); asm volatile("" ::: "memory");
        const f32x4 g0 = *(const f32x4*)(g + wc * 32 + 8 * fq), g1 = *(const f32x4*)(g + wc * 32 + 8 * fq + 4);
        f32x4 cs[2][2];
#pragma unroll
        for (int bj = 0; bj < 2; ++bj) { cs[bj][0] = (f32x4){0.f, 0.f, 0.f, 0.f}; cs[bj][1] = (f32x4){0.f, 0.f, 0.f, 0.f}; }
#pragma unroll
        for (int ai = 0; ai < 2; ++ai)
#pragma unroll
            for (int m = 0; m < 4; ++m) { bf16_t* rowp = Ob + (size_t)(row0 + ai * HALF + m * 16) * 128;
#pragma unroll
                for (int bj = 0; bj < 2; ++bj) { const f32x4 p = *(const PG8_LAS f32x4*)(X + ((ai * HALF + wr * 64 + m * 16 + fr) * 2 + bj) * 4);
                    const float rs = __builtin_amdgcn_rsqf(((p[0] + p[1]) + (p[2] + p[3])) * (1.0f / 128.0f) + RMS_EPS) * sc;
                    const f32x4 v0 = acc[ai][bj][m][0] * rs * g0, v1 = acc[ai][bj][m][1] * rs * g1;
                    cs[bj][0] += v0; cs[bj][1] += v1;
                    u32x4 w; w.x = cvt_pk_bf16(v0[0], v0[1]); w.y = cvt_pk_bf16(v0[2], v0[3]); w.z = cvt_pk_bf16(v1[0], v1[1]); w.w = cvt_pk_bf16(v1[2], v1[3]);
                    st16(rowp + bj * hstr, w); } }
        if (kmean != nullptr && !isq) {
#pragma unroll
            for (int bj = 0; bj < 2; ++bj)
#pragma unroll
                for (int n = 0; n < 2; ++n)
#pragma unroll
                    for (int j = 0; j < 4; ++j) { float s = cs[bj][n][j];
                        s += xshf<1>(s); s += xshf<2>(s); s += xshf<4>(s); s += xshf<8>(s);
                        if (fr == 0) atomicAdd(kmean + (size_t)u.pm * 4096 + (pn - k0) * BM + bj * HALF + wc * 32 + 8 * fq + 4 * n + j, s * (1.0f / 256.0f)); }
        }
    }
};
struct EpiResNorm {
    static constexpr bool PERM = true, AFTER_DRAIN = false, INIT_BASE = true;
    bf16_t* XB; int ldc; float* outf; float* PSS; PG8_LAS float* X;
    __device__ __forceinline__ void init(f32x4 (&acc)[2][2][4][2], const Unit& u, int wr, int wc, int fr, int fq) const {
        const int row0 = u.pm * BM + wr * 64 + fr, col0 = u.pn * BM + wc * 32 + 8 * fq;
        u32x4 raw[2][4][2];
#pragma unroll
        for (int ai = 0; ai < 2; ++ai)
#pragma unroll
            for (int m = 0; m < 4; ++m)
#pragma unroll
                for (int bj = 0; bj < 2; ++bj) raw[ai][m][bj] = *(const u32x4*)(XB + (size_t)(row0 + ai * HALF + m * 16) * ldc + col0 + bj * HALF);
#pragma unroll
        for (int ai = 0; ai < 2; ++ai)
#pragma unroll
            for (int m = 0; m < 4; ++m)
#pragma unroll
                for (int bj = 0; bj < 2; ++bj) { const u32x4 r = raw[ai][m][bj];
                    acc[ai][bj][m][0] = (f32x4){__uint_as_float(r.x << 16), __uint_as_float(r.x & 0xffff0000u), __uint_as_float(r.y << 16), __uint_as_float(r.y & 0xffff0000u)};
                    acc[ai][bj][m][1] = (f32x4){__uint_as_float(r.z << 16), __uint_as_float(r.z & 0xffff0000u), __uint_as_float(r.w << 16), __uint_as_float(r.w & 0xffff0000u)}; }
    }
    __device__ __forceinline__ void operator()(const f32x4 (&acc)[2][2][4][2], const Unit& u, int wr, int wc, int fr, int fq) const {
        const int row0 = u.pm * BM + wr * 64 + fr, col0 = u.pn * BM + wc * 32 + 8 * fq;
#pragma unroll
        for (int ai = 0; ai < 2; ++ai)
#pragma unroll
            for (int m = 0; m < 4; ++m) { const size_t off = (size_t)(row0 + ai * HALF + m * 16) * ldc + col0;
                float ss = 0.f;
#pragma unroll
                for (int bj = 0; bj < 2; ++bj) { const f32x4 v0 = acc[ai][bj][m][0], v1 = acc[ai][bj][m][1];
                    if (outf != nullptr) { st16f(outf + off + bj * HALF, v0); st16f(outf + off + bj * HALF + 4, v1); }
                    else { const f32x4 q4 = v0 * v0 + v1 * v1; ss += (q4[0] + q4[1]) + (q4[2] + q4[3]);
                        u32x4 w; w.x = cvt_pk_bf16(v0[0], v0[1]); w.y = cvt_pk_bf16(v0[2], v0[3]); w.z = cvt_pk_bf16(v1[0], v1[1]); w.w = cvt_pk_bf16(v1[2], v1[3]);
                        st16(XB + off + bj * HALF, w); } }
                if (outf == nullptr) { ss += xshf<16>(ss); ss += xshf<32>(ss); if (fq == 0) X[(ai * HALF + wr * 64 + m * 16 + fr) * 4 + wc] = ss; } }
        if (outf == nullptr) {
            asm volatile("s_waitcnt lgkmcnt(0)" ::: "memory"); __builtin_amdgcn_s_barrier(); asm volatile("" ::: "memory");
            const int t = (wr * 4 + wc) * 64 + fq * 16 + fr;
            if (t < BM) { const f32x4 p = *(const PG8_LAS f32x4*)(X + t * 4); PSS[(size_t)(u.pm * BM + t) * 16 + u.pn] = (p[0] + p[1]) + (p[2] + p[3]); }
        }
    }
};
struct EpiSwiGLU {
    static constexpr bool PERM = true, AFTER_DRAIN = false, INIT_BASE = false;
    bf16_t* H; int ldh; const float* pss; PG8_LAS float* rt;
    static __device__ __forceinline__ f32x4 sw4(const f32x4 g, const f32x4 up, const f32x2 rs) {
        const f32x4 t = g * rs[0];
        f32x4 d = {__builtin_amdgcn_exp2f(t[0]), __builtin_amdgcn_exp2f(t[1]), __builtin_amdgcn_exp2f(t[2]), __builtin_amdgcn_exp2f(t[3])};
        d = d + 1.0f;
        f32x4 r = {__builtin_amdgcn_rcpf(d[0]), __builtin_amdgcn_rcpf(d[1]), __builtin_amdgcn_rcpf(d[2]), __builtin_amdgcn_rcpf(d[3])};
        r = r * rs[1];
        return (g * up) * r;
    }
    __device__ __forceinline__ void operator()(const f32x4 (&acc)[2][2][4][2], const Unit& u, int wr, int wc, int fr, int fq) const {
        const int row0 = u.pm * BM + wr * 64 + fr, col0 = u.pn * HALF + wc * 32 + 8 * fq;
        rstd_panel(rt, pss, u.pm, (wr * 4 + wc) * 64 + fq * 16 + fr);
#pragma unroll
        for (int ai = 0; ai < 2; ++ai)
#pragma unroll
            for (int m = 0; m < 4; ++m) { const float rr = rt[1 + ai * HALF + wr * 64 + m * 16 + fr];
                const f32x2 rs = {rr * -1.4426950408889634f, rr * rr};
                const f32x4 ha = sw4(acc[ai][0][m][0], acc[ai][1][m][0], rs), hb = sw4(acc[ai][0][m][1], acc[ai][1][m][1], rs);
                u32x4 w; w.x = cvt_pk_bf16(ha[0], ha[1]); w.y = cvt_pk_bf16(ha[2], ha[3]); w.z = cvt_pk_bf16(hb[0], hb[1]); w.w = cvt_pk_bf16(hb[2], hb[3]);
                st16(H + (size_t)(row0 + ai * HALF + m * 16) * ldh + col0, w); }
    }
};

template <class Epi, class Sched, bool ALIGN_EPI = false, bool SP2 = false, bool A_HM = false, bool B_BLK = true>
__device__ __forceinline__ void gemm_phase(PG8_LAS unsigned char* lds, const Gemm g, const Sched& S, const Epi& E) {
    int tid_ = threadIdx.x; asm volatile("" : "+v"(tid_)); tid_ &= 511;
    const int tid = tid_, wid = __builtin_amdgcn_readfirstlane(tid >> 6), lane = tid & 63, wr = wid >> 2, wc = wid & 3, fr = lane & 15, fq = lane >> 4;
    const int K = g.K, nt = K / BK;
    unsigned voffA[2], voffB[2];
#pragma unroll
    for (int i = 0; i < 2; ++i) { int R, C; stage_rc(tid * 16 + i * 8192, R, C); const int Rb = Epi::PERM ? ((R & ~31) + perm32(R & 31)) : R;
        voffA[i] = (unsigned)(R * (A_HM ? 128 : K) + C) * 2u; voffB[i] = (unsigned)(Rb * (B_BLK ? 64 : K) + C) * 2u; }
    const size_t kstep = (size_t)(BK * 2);
    const size_t hstep = (size_t)HALF * K * 2;
    const size_t tstep = 2 * hstep;
    const size_t hstepA = A_HM ? (size_t)HALF * 256 : hstep, tstepA = 2 * hstepA, headA = (size_t)g.M * 256;
    const size_t kstepB = B_BLK ? (size_t)32768 : kstep, hstepB = B_BLK ? (size_t)16384 : hstep;
#define PG8_AK(t) (A_HM ? (size_t)((t) >> 1) * headA + (size_t)((t) & 1) * 128 : (size_t)(t) * kstep)
    const unsigned ldsw = (unsigned)wid * 1024u;
    const int aoff = lds_byte(wr * 64 + fr, fq * 8), boff = lds_byte(wc * 32 + fr, fq * 8);
#define PG8_SA(b, h) (((b) * 2 + (h)) * HTB)
#define PG8_SB(b, h) ((4 + (b) * 2 + (h)) * HTB)
#define PG8_STAGE(bufoff, gbase, voff) do { _Pragma("unroll") for (int _i = 0; _i < 2; ++_i) \
        __builtin_amdgcn_global_load_lds((const unsigned*)((const char*)(gbase) + (voff)[_i]), (PG8_LAS unsigned*)(lds + (bufoff) + ldsw + _i * 8192), 16, 0, 0); } while (0)
#define PG8_LDA(dst, b, h) do { _Pragma("unroll") for (int m = 0; m < 4; ++m) _Pragma("unroll") for (int k = 0; k < 2; ++k) dst[m][k] = *(const PG8_LAS bf16x8*)(lds + PG8_SA(b, h) + aoff + m * 2048 + k * 1024); } while (0)
#define PG8_LDB(dst, b, h) do { _Pragma("unroll") for (int n = 0; n < 2; ++n) _Pragma("unroll") for (int k = 0; k < 2; ++k) dst[n][k] = *(const PG8_LAS bf16x8*)(lds + PG8_SB(b, h) + boff + n * 2048 + k * 1024); } while (0)
#define PG8_MMA(ai, bj, At, Bt) do { __builtin_amdgcn_s_setprio(1); _Pragma("unroll") for (int m = 0; m < 4; ++m) _Pragma("unroll") for (int n = 0; n < 2; ++n) _Pragma("unroll") for (int k = 0; k < 2; ++k) \
        acc[ai][bj][m][n] = __builtin_amdgcn_mfma_f32_16x16x32_bf16(Bt[n][k], At[m][k], acc[ai][bj][m][n], 0, 0, 0); __builtin_amdgcn_s_setprio(0); } while (0)
#define PG8_WAIT_V(n) asm volatile("s_waitcnt vmcnt(" #n ")" ::: "memory")
#define PG8_WAIT_L(n) asm volatile("s_waitcnt lgkmcnt(" #n ")" ::: "memory")
#define PG8_BAR __builtin_amdgcn_s_barrier()
#define PG8_SCHED __builtin_amdgcn_sched_barrier(0)
#define PG8_ACC_INIT(U) do { if constexpr (Epi::INIT_BASE) { E.init(acc, (U), wr, wc, fr, fq); \
        _Pragma("unroll") for (int a = 0; a < 2; ++a) _Pragma("unroll") for (int b = 0; b < 2; ++b) _Pragma("unroll") for (int m = 0; m < 4; ++m) _Pragma("unroll") for (int n = 0; n < 2; ++n) asm volatile("" : "+v"(acc[a][b][m][n])); } \
    else { _Pragma("unroll") for (int a = 0; a < 2; ++a) _Pragma("unroll") for (int b = 0; b < 2; ++b) _Pragma("unroll") for (int m = 0; m < 4; ++m) _Pragma("unroll") for (int n = 0; n < 2; ++n) acc[a][b][m][n] = (f32x4){0.f, 0.f, 0.f, 0.f}; } } while (0)
    Unit cur, nxt; int ui = 0;
    if (!S.next(0, cur)) return;
    f32x4 acc[2][2][4][2];
    PG8_ACC_INIT(cur);
    bf16x8 At[4][2], B0[2][2], B1[2][2];
    const char* cA = (const char*)g.A + (size_t)cur.pm * tstepA; const char* cB = (const char*)g.Bt + (size_t)cur.pn * tstep;
    S.a_ready(cur);
    if constexpr (SP2) {
        PG8_STAGE(PG8_SB(0, 0), cB, voffB); PG8_STAGE(PG8_SB(0, 1), cB + hstepB, voffB); PG8_STAGE(PG8_SA(0, 0), cA, voffA); PG8_STAGE(PG8_SA(0, 1), cA + hstepA, voffA);
        if (wr == 1) PG8_BAR;
        PG8_WAIT_V(2); PG8_BAR;
        PG8_STAGE(PG8_SB(1, 0), cB + kstepB, voffB); PG8_STAGE(PG8_SA(1, 0), cA + kstep, voffA); PG8_STAGE(PG8_SB(1, 1), cB + hstepB + kstepB, voffB);
        PG8_WAIT_V(6); PG8_BAR;
    } else {
        PG8_STAGE(PG8_SB(0, 0), cB, voffB); PG8_STAGE(PG8_SA(0, 0), cA, voffA); PG8_STAGE(PG8_SB(0, 1), cB + hstepB, voffB); PG8_STAGE(PG8_SA(0, 1), cA + hstepA, voffA);
        if (wr == 1) PG8_BAR;
        PG8_WAIT_V(4); PG8_BAR;
        PG8_STAGE(PG8_SB(1, 0), cB + kstepB, voffB); PG8_STAGE(PG8_SA(1, 0), cA + kstep, voffA); PG8_STAGE(PG8_SB(1, 1), cB + hstepB + kstepB, voffB);
        PG8_WAIT_V(6); PG8_BAR;
    }
    for (;;) {
        const bool has_next = S.next(ui + 1, nxt);
        const char* nA = has_next ? (const char*)g.A + (size_t)nxt.pm * tstepA : cA; const char* nB = has_next ? (const char*)g.Bt + (size_t)nxt.pn * tstep : cB;
        for (int t = 0; t < nt; t += 2) {
            const bool last = (t == nt - 2);
            const char* a1 = cA + PG8_AK(t + 1);
            const char* a2 = last ? nA : cA + PG8_AK(t + 2); const char* b2 = last ? nB : cB + (size_t)(t + 2) * kstepB;
            const char* a3 = a2 + kstep; const char* b3 = b2 + kstepB;
            if (last && has_next) S.a_ready(nxt);
            if constexpr (SP2) {
            PG8_LDB(B0, 0, 0); PG8_LDB(B1, 0, 1); PG8_SCHED; PG8_LDA(At, 0, 0); PG8_STAGE(PG8_SA(1, 1), a1 + hstepA, voffA);
            PG8_WAIT_V(8); PG8_WAIT_L(0); PG8_BAR; PG8_MMA(0, 0, At, B0); PG8_MMA(0, 1, At, B1); PG8_BAR; PG8_SCHED;
            PG8_LDA(At, 0, 1); PG8_STAGE(PG8_SB(0, 0), b2, voffB); PG8_STAGE(PG8_SB(0, 1), b2 + hstepB, voffB); PG8_STAGE(PG8_SA(0, 0), a2, voffA);
            PG8_WAIT_V(8); PG8_WAIT_L(0); PG8_BAR; PG8_MMA(1, 0, At, B0); PG8_MMA(1, 1, At, B1); PG8_BAR; PG8_SCHED;
            PG8_LDB(B0, 1, 0); PG8_LDB(B1, 1, 1); PG8_SCHED; PG8_LDA(At, 1, 0); PG8_STAGE(PG8_SA(0, 1), a2 + hstepA, voffA);
            PG8_WAIT_V(8); PG8_WAIT_L(0); PG8_BAR; PG8_MMA(0, 0, At, B0); PG8_MMA(0, 1, At, B1); PG8_BAR; PG8_SCHED;
            PG8_LDA(At, 1, 1); PG8_STAGE(PG8_SB(1, 0), b3, voffB); PG8_STAGE(PG8_SB(1, 1), b3 + hstepB, voffB); PG8_STAGE(PG8_SA(1, 0), a3, voffA);
            PG8_WAIT_V(8); PG8_WAIT_L(0); PG8_BAR; PG8_MMA(1, 0, At, B0); PG8_MMA(1, 1, At, B1); PG8_BAR; PG8_SCHED;
            } else {
            PG8_LDB(B0, 0, 0); PG8_SCHED; PG8_LDA(At, 0, 0); PG8_STAGE(PG8_SA(1, 1), a1 + hstepA, voffA);
            PG8_WAIT_L(8); PG8_BAR; PG8_WAIT_L(0); PG8_MMA(0, 0, At, B0); PG8_BAR; PG8_SCHED;
            PG8_LDB(B1, 0, 1); PG8_STAGE(PG8_SB(0, 0), b2, voffB);
            PG8_BAR; PG8_WAIT_L(0); PG8_MMA(0, 1, At, B1); PG8_BAR;
            PG8_LDA(At, 0, 1); PG8_STAGE(PG8_SA(0, 0), a2, voffA);
            PG8_BAR; PG8_WAIT_L(0); PG8_MMA(1, 0, At, B0); PG8_BAR; PG8_SCHED;
            PG8_STAGE(PG8_SB(0, 1), b2 + hstepB, voffB);
            PG8_WAIT_V(6); PG8_BAR; PG8_MMA(1, 1, At, B1); PG8_BAR;
            PG8_LDB(B0, 1, 0); PG8_SCHED; PG8_LDA(At, 1, 0); PG8_STAGE(PG8_SA(0, 1), a2 + hstepA, voffA);
            PG8_WAIT_L(8); PG8_BAR; PG8_WAIT_L(0); PG8_MMA(0, 0, At, B0); PG8_BAR; PG8_SCHED;
            PG8_LDB(B1, 1, 1); PG8_STAGE(PG8_SB(1, 0), b3, voffB);
            PG8_BAR; PG8_WAIT_L(0); PG8_MMA(0, 1, At, B1); PG8_BAR;
            PG8_LDA(At, 1, 1); PG8_STAGE(PG8_SA(1, 0), a3, voffA);
            PG8_BAR; PG8_WAIT_L(0); PG8_MMA(1, 0, At, B0); PG8_BAR; PG8_SCHED;
            PG8_STAGE(PG8_SB(1, 1), b3 + hstepB, voffB);
            PG8_WAIT_V(6); PG8_BAR; PG8_MMA(1, 1, At, B1); PG8_BAR;
            }
        }
        if constexpr (ALIGN_EPI) { if (wr == 0) PG8_BAR; }
        if constexpr (!Epi::AFTER_DRAIN) { E(acc, cur, wr, wc, fr, fq); S.done(cur); }
        if (!has_next) break;
        PG8_ACC_INIT(nxt);
        cur = nxt; cA = nA; cB = nB; ++ui;
        if constexpr (ALIGN_EPI) { if (wr == 1) PG8_BAR; }
    }
    PG8_WAIT_V(0);
    if constexpr (!ALIGN_EPI) { if (wr == 0) PG8_BAR; }
    PG8_BAR;
    if constexpr (Epi::AFTER_DRAIN) { E.fused(acc, cur, wr, wc, fr, fq, lds, wid, lane); S.done(cur); }
#undef PG8_SA
#undef PG8_SB
#undef PG8_STAGE
#undef PG8_LDA
#undef PG8_LDB
#undef PG8_MMA
#undef PG8_WAIT_V
#undef PG8_WAIT_L
#undef PG8_BAR
#undef PG8_SCHED
#undef PG8_AK
#undef PG8_ACC_INIT
}
}

constexpr int NWAVES = 8;
constexpr int S = 8192, D = 4096, NH = 32, HD = 128, DFF = 11008, NQKV = 5 * D, NGU = 2 * DFF;
constexpr float LOG2E = 1.4426950408889634f;
constexpr float QSCALE = 0.08838834764831845f * LOG2E;
constexpr float M2_QK = 11.313708498984761f * LOG2E;
#ifndef MK_PER_PHASE
#define MK_PER_PHASE 0
#endif
constexpr int N_PHASES = 17;

constexpr size_t MiB = 1u << 20;
constexpr size_t WS_CTL = 0, CTL_ZERO_BYTES = 640 * 1024;
constexpr size_t WS_KMEAN = 64 * 1024;
constexpr size_t WS_PSS = 2 * MiB;
constexpr size_t WS_WQKV = 4 * MiB;
constexpr size_t WS_WOA  = WS_WQKV + 160 * MiB;
constexpr size_t WS_WGU  = WS_WOA + 32 * MiB;
constexpr size_t WS_WDN  = WS_WGU + 344 * MiB;
constexpr size_t WS_WKV  = WS_WDN + 172 * MiB;
constexpr size_t WS_WQB  = WS_WKV + 64 * MiB;
constexpr size_t WS_WOB  = WS_WQB + 32 * MiB;
constexpr size_t WS_HN   = WS_WOB + 32 * MiB;
constexpr size_t WS_HN2  = WS_HN + 64 * MiB;
constexpr size_t WS_PROJ = WS_HN2 + 64 * MiB;
constexpr size_t WS_PART = WS_PROJ + 320 * MiB;
constexpr size_t WS_LPART = WS_PART + 192 * MiB;
constexpr size_t WS_OB   = WS_LPART + 4 * MiB;
constexpr size_t WS_X1   = WS_OB + 64 * MiB;
constexpr size_t WS_X2   = WS_X1 + 128 * MiB;
constexpr size_t WS_HID  = WS_X2 + 128 * MiB;
constexpr size_t WS_SEL  = WS_HID + 172 * MiB;
constexpr size_t WS_END  = WS_SEL + 1 * MiB;
constexpr int CW_TMO = 0, CW_CODE = 1, CW_BAR = 4096, CW_QUEUE = 8192, CW_CVTB = 8256, CW_CVTC = 8320, CW_CVTA = 8384;

constexpr int RING_OFF = 0, RING_BYTES = 131072;
constexpr int X_OFF = RING_BYTES, X_BYTES = 8192;
constexpr int LIST_OFF = X_OFF + X_BYTES, LIST_BYTES = 12288;
constexpr int LDSCTL_OFF = LIST_OFF + LIST_BYTES, MISC_OFF = LDSCTL_OFF + 320;
constexpr int BIAS_OFF = LDSCTL_OFF + 512, BIAS_BYTES = 4096;
constexpr int LDS_BYTES = BIAS_OFF + BIAS_BYTES;
#define GAS __attribute__((address_space(1)))
#define LAS __attribute__((address_space(3)))
typedef unsigned short bf16;
typedef unsigned v4u __attribute__((ext_vector_type(4)));
typedef float f32x4 __attribute__((ext_vector_type(4)));
typedef short bf16x8 __attribute__((ext_vector_type(8)));
typedef GAS unsigned gu32;
typedef GAS unsigned long long gu64;
#define RLX_AGENT __ATOMIC_RELAXED, __HIP_MEMORY_SCOPE_AGENT
#define LDS_WAIT() asm volatile("s_waitcnt lgkmcnt(0)" ::: "memory")
#define VM_WAIT() asm volatile("s_waitcnt vmcnt(0)" ::: "memory")
__device__ __forceinline__ unsigned long long rt() { return __builtin_amdgcn_s_memrealtime(); }
__device__ __forceinline__ unsigned f2bf(float f) { unsigned u = __builtin_bit_cast(unsigned, f); return (u + 0x7fffu + ((u >> 16) & 1u)) >> 16; }
__device__ __forceinline__ unsigned pk2(float lo, float hi) { return f2bf(lo) | (f2bf(hi) << 16); }

#define XB_TMO      128
#define XB_XCNT(j)  (256  + 64 * (j))
#define XB_XSUB(j)  (1280 + 64 * (j))
#define XB_XGEN(j)  (2304 + 64 * (j))
#define XB_TOP      3328
#define XB_TOPGEN   3392
#define XCD_BAR_WORDS 3456
#define XB_SPIN_CAP (1u << 18)

__device__ __forceinline__ unsigned xb_ld(unsigned* p)              { return __hip_atomic_load(p, __ATOMIC_RELAXED, __HIP_MEMORY_SCOPE_AGENT); }
__device__ __forceinline__ unsigned xb_add(unsigned* p, unsigned v) { return __hip_atomic_fetch_add(p, v, __ATOMIC_RELAXED, __HIP_MEMORY_SCOPE_AGENT); }
__device__ __forceinline__ unsigned xb_xcc_id() { return (unsigned)__builtin_amdgcn_s_getreg((3 << 11) | 20) & 0xFu; }
#define XB_SPIN(cond, bar) do { unsigned _sp = 0; while (cond) { __builtin_amdgcn_s_sleep(1); \
    if ((++_sp & 255u) == 0u) { if (xb_ld(&(bar)[XB_TMO])) break; if (_sp > XB_SPIN_CAP) { atomicAdd(&(bar)[XB_TMO], 1u); break; } } } } while (0)

struct XcdBarrier {
    unsigned* bar; unsigned x;
    volatile LAS unsigned* st;
};

__device__ __forceinline__ XcdBarrier xcd_barrier_post(unsigned* bar, volatile LAS unsigned* st) {
    XcdBarrier b; b.bar = bar; b.x = xb_xcc_id(); b.st = st;
    if (threadIdx.x == 0) (void)xb_add(&bar[XB_XCNT(b.x)], 1u);
    return b;
}
__device__ __forceinline__ void xcd_barrier_complete(unsigned* bar, unsigned x, unsigned& nloc, unsigned& nx) {
    const unsigned G = gridDim.x * gridDim.y * gridDim.z;
    unsigned sum, cnt, mine, sp = 0u;
    for (;;) {
        sum = 0u; cnt = 0u; mine = 0u;
#pragma unroll
        for (unsigned j = 0; j < 16; ++j) { const unsigned c = xb_ld(&bar[XB_XCNT(j)]); sum += c; cnt += (c > 0u) ? 1u : 0u; mine = (j == x) ? c : mine; }
        if (sum == G) break;
        __builtin_amdgcn_s_sleep(1);
        if ((++sp & 255u) == 0u) { if (xb_ld(&bar[XB_TMO])) break; if (sp > XB_SPIN_CAP) { atomicAdd(&bar[XB_TMO], 1u); break; } }
    }
    nloc = mine > 0u ? mine : 1u; nx = cnt > 0u ? cnt : 1u;
}

__device__ __forceinline__ void xcd_barrier(const XcdBarrier& b) {
    asm volatile("s_waitcnt vmcnt(0)" ::: "memory");
    __syncthreads();
    if (threadIdx.x == 0) {
        unsigned* bar = b.bar;
        __builtin_amdgcn_s_waitcnt(0);
        unsigned nloc = b.st[0], nx = b.st[1];
        if (nloc == 0u) { xcd_barrier_complete(bar, b.x, nloc, nx); b.st[0] = nloc; b.st[1] = nx; }
        const unsigned old = xb_add(&bar[XB_XSUB(b.x)], 1u);
        const unsigned gen = old / nloc;
        if (old + 1u == (gen + 1u) * nloc) {
            __builtin_amdgcn_fence(__ATOMIC_RELEASE, "agent");
            asm volatile("s_waitcnt vmcnt(0)" ::: "memory");
            const unsigned og = xb_add(&bar[XB_TOP], 1u);
            const unsigned tg = og / nx;
            if (og + 1u == (tg + 1u) * nx) xb_add(&bar[XB_TOPGEN], 1u);
            else XB_SPIN(xb_ld(&bar[XB_TOPGEN]) == tg, bar);
            __builtin_amdgcn_fence(__ATOMIC_ACQUIRE, "agent");
            xb_add(&bar[XB_XGEN(b.x)], 1u);
            asm volatile("s_waitcnt vmcnt(0)" ::: "memory");
        } else {
            XB_SPIN(xb_ld(&bar[XB_XGEN(b.x)]) == gen, bar);
            __builtin_amdgcn_fence(__ATOMIC_ACQUIRE, "agent");
            asm volatile("s_waitcnt vmcnt(0)" ::: "memory");
        }
    }
    __syncthreads();
}


typedef short s16x4 __attribute__((ext_vector_type(4)));
typedef float f32x2 __attribute__((ext_vector_type(2)));
typedef __bf16 bf16x2v __attribute__((ext_vector_type(2)));
struct Args { const float* in[16]; float* out; unsigned char* ws; int ph_lo, ph_hi; };
#define KARGS() ((const __attribute__((address_space(4))) Args*)__builtin_amdgcn_kernarg_segment_ptr())
#define INP(k) (KARGS()->in[k])
#define OUTP() (KARGS()->out)
struct Frame {
    LAS unsigned char* lds;
    volatile LAS unsigned* MISC;
    gu32* ctl;
    unsigned char* ws;
    int tid, lane, wave, vcu, G;
};
__device__ __forceinline__ unsigned pkbf(float lo, float hi) { const f32x2 v = {lo, hi}; return __builtin_bit_cast(unsigned, __builtin_convertvector(v, bf16x2v)); }
__device__ __forceinline__ float bflo(unsigned u) { return __builtin_bit_cast(float, u << 16); }
__device__ __forceinline__ float bfhi(unsigned u) { return __builtin_bit_cast(float, u & 0xffff0000u); }
__device__ __forceinline__ float wave_sum(float v) {
    v += xshf<1>(v); v += xshf<2>(v); v += xshf<4>(v); v += xshf<8>(v); v += xshf<16>(v); v += xshf<32>(v);
    return v;
}
__device__ __forceinline__ float wave_max(float v) {
    v = fmaxf(v, xshf<1>(v)); v = fmaxf(v, xshf<2>(v)); v = fmaxf(v, xshf<4>(v)); v = fmaxf(v, xshf<8>(v)); v = fmaxf(v, xshf<16>(v)); v = fmaxf(v, xshf<32>(v));
    return v;
}
__device__ __forceinline__ int t5_bucket(int n) {
    if (n < 16) return n;
    return 16 + (n >= 22) + (n >= 30) + (n >= 40) + (n >= 54) + (n >= 73) + (n >= 99) + (n >= 134) + (n >= 182) + (n >= 246) + (n >= 332) + (n >= 450) + (n >= 609) + (n >= 825) + (n >= 1117) + (n >= 1513);
}
__device__ __forceinline__ float softmax_offset(const Frame& F, const float* gq, int ngq, const float* gk, int ngk) {
    float a = 0.f, b = 0.f, c = 0.f;
    for (int i = F.lane; i < ngq; i += 64) a = fmaxf(a, fabsf(gq[i]));
    for (int i = F.lane; i < ngk; i += 64) b = fmaxf(b, fabsf(gk[i]));
    for (int i = F.lane; i < 1024; i += 64) c = fmaxf(c, fabsf(INP(1)[i]));
    return M2_QK * wave_max(a) * wave_max(b) + LOG2E * wave_max(c);
}

struct CvtItem { const float* W; bf16* WT; const float* gain; int K, N, mode, idx; };
constexpr int I_QKV = (D / 64) * (NQKV / 32), I_DD = (D / 64) * (D / 32), I_GU = (D / 64) * (NGU / 32), I_DN = (DFF / 64) * (D / 32), I_KV = (D / 64) * (2 * D / 32);
constexpr int CVT_A_END = I_QKV + I_DD + I_GU + I_DN + I_DD + I_GU;
constexpr int CVT_B_END = CVT_A_END + I_KV + I_DD;
constexpr int CVT_C_END = CVT_B_END + I_DN;
__device__ __forceinline__ CvtItem cvt_describe(const Frame& F, int it) {
    int r = it;
    if (r < I_QKV) return CvtItem{INP(4), (bf16*)(F.ws + WS_WQKV), INP(2), D, NQKV, 0, r}; r -= I_QKV;
    if (r < I_DD) return CvtItem{INP(7), (bf16*)(F.ws + WS_WOA), nullptr, D, D, 0, r}; r -= I_DD;
    if (r < I_GU) return CvtItem{INP(14), (bf16*)(F.ws + WS_WGU), INP(3), D, NGU, 1, r}; r -= I_GU;
    if (r < I_DN) return CvtItem{INP(15), (bf16*)(F.ws + WS_WDN), nullptr, DFF, D, 0, r}; r -= I_DN;
    if (r < I_DD) return CvtItem{INP(13), (bf16*)(F.ws + WS_WOB), nullptr, D, D, 0, r}; r -= I_DD;
    if (r < I_GU) return CvtItem{INP(14) + (size_t)D * NGU, (bf16*)(F.ws + WS_WGU) + (size_t)NGU * D, INP(3) + D, D, NGU, 1, r}; r -= I_GU;
    if (r < I_KV) return CvtItem{INP(9), (bf16*)(F.ws + WS_WKV), INP(8), D, 2 * D, 0, r}; r -= I_KV;
    if (r < I_DD) return CvtItem{INP(11), (bf16*)(F.ws + WS_WQB), INP(2) + D, D, D, 0, r}; r -= I_DD;
    return CvtItem{INP(15) + (size_t)DFF * D, (bf16*)(F.ws + WS_WDN) + (size_t)D * DFF, nullptr, DFF, D, 0, r};
}
__device__ __forceinline__ void cvt_load(const CvtItem& d, int lane, float (&wv)[32]) {
    const int nblk = d.N / 32, kb = d.idx / nblk, nb = d.idx % nblk, k0 = 64 * kb, n0 = 32 * nb;
#pragma unroll
    for (int i = 0; i < 8; ++i) { const f32x4 v = __builtin_nontemporal_load((const GAS f32x4*)(d.W + (size_t)(k0 + 8 * i + (lane >> 3)) * d.N + n0 + 4 * (lane & 7)));
        wv[4 * i] = v[0]; wv[4 * i + 1] = v[1]; wv[4 * i + 2] = v[2]; wv[4 * i + 3] = v[3]; }
}
__device__ __forceinline__ void cvt_store(const CvtItem& d, int lane, const float (&wv)[32], LAS float* scr) {
    const int nblk = d.N / 32, kb = d.idx / nblk, nb = d.idx % nblk, k0 = 64 * kb, n0 = 32 * nb;
#pragma unroll
    for (int i = 0; i < 8; ++i)
#pragma unroll
        for (int j = 0; j < 4; ++j) scr[(8 * i + (lane >> 3)) * 33 + 4 * (lane & 7) + j] = wv[4 * i + j];
    LDS_WAIT(); asm volatile("" ::: "memory");
    int r0 = n0;
    if (d.mode == 1) { const int up = n0 >= DFF, j = up ? n0 - DFF : n0; r0 = 256 * (j >> 7) + (up ? 128 : 0) + (j & 127); }
    const int c = lane & 7;
    f32x4 ga = {1.f, 1.f, 1.f, 1.f}, gb = {1.f, 1.f, 1.f, 1.f};
    if (d.gain != nullptr) { ga = *(const GAS f32x4*)(d.gain + k0 + 8 * c); gb = *(const GAS f32x4*)(d.gain + k0 + 8 * c + 4); }
#pragma unroll
    for (int j = 0; j < 4; ++j) { const int n = (lane >> 3) + 8 * j; const LAS float* s = scr + (8 * c) * 33 + n;
        v4u o; o.x = pkbf(s[0 * 33] * ga[0], s[1 * 33] * ga[1]); o.y = pkbf(s[2 * 33] * ga[2], s[3 * 33] * ga[3]); o.z = pkbf(s[4 * 33] * gb[0], s[5 * 33] * gb[1]); o.w = pkbf(s[6 * 33] * gb[2], s[7 * 33] * gb[3]);
        const int rr = r0 + n;
        __builtin_nontemporal_store(o, (GAS v4u*)(d.WT + ((size_t)(rr >> 8) * (d.K / 64) + kb) * 16384 + (size_t)(rr & 255) * 64 + 8 * c)); }
    LDS_WAIT(); asm volatile("" ::: "memory");
}
__device__ __forceinline__ void convert_items(Frame& F, int lo, int hi, int gw, int NGW) {
    LAS float* scr = (LAS float*)(F.lds + RING_OFF + F.wave * 16384);
    for (int it = lo + gw; it < hi; it += 2 * NGW) {
        const CvtItem a = cvt_describe(F, lo + hi - 1 - it); float wa[32]; cvt_load(a, F.lane, wa);
        const bool hasb = it + NGW < hi;
        if (hasb) { const CvtItem b = cvt_describe(F, lo + hi - 1 - (it + NGW)); float wb[32]; cvt_load(b, F.lane, wb); cvt_store(a, F.lane, wa, scr); cvt_store(b, F.lane, wb, scr); }
        else cvt_store(a, F.lane, wa, scr);
    }
}
__device__ __forceinline__ void cvt_rows(Frame& F, const float* X, bf16* xb, float* pss) {
    const int gw = F.vcu * NWAVES + F.wave, NGW = F.G * NWAVES;
    for (int m = gw; m < S; m += NGW) {
        const GAS f32x4* xr = (const GAS f32x4*)(X + (size_t)m * D) + F.lane;
        f32x4 v[16]; float s = 0.f;
#pragma unroll
        for (int j = 0; j < 16; ++j) { v[j] = xr[64 * j]; s += (v[j].x * v[j].x + v[j].y * v[j].y) + (v[j].z * v[j].z + v[j].w * v[j].w); }
        s = wave_sum(s);
        GAS unsigned long long* o8 = (GAS unsigned long long*)(xb + (size_t)m * D) + F.lane;
#pragma unroll
        for (int j = 0; j < 16; ++j) o8[64 * j] = (unsigned long long)pkbf(v[j].x, v[j].y) | ((unsigned long long)pkbf(v[j].z, v[j].w) << 32);
        if (F.lane < 16) pss[(size_t)m * 16 + F.lane] = F.lane == 0 ? s : 0.f;
    }
}
__device__ __forceinline__ void convert_queue(Frame& F, int lo, int hi, gu32* ctr) {
    LAS float* scr = (LAS float*)(F.lds + RING_OFF + F.wave * 16384);
    constexpr unsigned CH = 16u;
    unsigned c = 0u; if (F.lane == 0) c = __hip_atomic_fetch_add(ctr, CH, __ATOMIC_RELAXED, __HIP_MEMORY_SCOPE_AGENT);
    int base = lo + __builtin_amdgcn_readfirstlane((int)c);
    while (base < hi) {
        unsigned cn = 0u; if (F.lane == 0) cn = __hip_atomic_fetch_add(ctr, CH, __ATOMIC_RELAXED, __HIP_MEMORY_SCOPE_AGENT);
        const int end = base + (int)CH < hi ? base + (int)CH : hi;
        for (int it = base; it < end; it += 2) {
            const CvtItem a = cvt_describe(F, it); float wa[32]; cvt_load(a, F.lane, wa);
            if (it + 1 < end) { const CvtItem b = cvt_describe(F, it + 1); float wb[32]; cvt_load(b, F.lane, wb); cvt_store(a, F.lane, wa, scr); cvt_store(b, F.lane, wb, scr); }
            else cvt_store(a, F.lane, wa, scr);
        }
        base = lo + __builtin_amdgcn_readfirstlane((int)cn);
    }
}
__device__ __forceinline__ void p0_prologue(Frame& F) {
    const int gw = F.vcu * NWAVES + F.wave, NGW = F.G * NWAVES;
    convert_items(F, 0, I_QKV, gw, NGW);
    cvt_rows(F, INP(0), ((bf16*)(F.ws + (WS_HN))), ((float*)(F.ws + (WS_PSS))));
}

constexpr int K_OFF = 0, V_OFF = 65536;
__device__ __forceinline__ unsigned offb(unsigned row, unsigned ch) { return 256u * row + 16u * (ch ^ (((row & 3u) << 2) | ((row >> 2) & 3u))); }
__device__ __forceinline__ void stage_kv(Frame& F, const bf16* kbase, const bf16* vbase, size_t rstride, int first_valid) {
    v4u kr[8], vr[8];
#pragma unroll
    for (int it = 0; it < 8; ++it) { const int idx = F.tid + 512 * it, row = idx >> 4, ch = idx & 15;
        if (row >= first_valid) { kr[it] = *(const GAS v4u*)(kbase + (size_t)row * rstride + ch * 8); vr[it] = *(const GAS v4u*)(vbase + (size_t)row * rstride + ch * 8); }
        else { kr[it] = (v4u){0u, 0u, 0u, 0u}; vr[it] = (v4u){0u, 0u, 0u, 0u}; } }
#pragma unroll
    for (int it = 0; it < 8; ++it) { const int idx = F.tid + 512 * it, row = idx >> 4, ch = idx & 15; const unsigned o = offb(row, ch);
        *(LAS v4u*)(F.lds + K_OFF + o) = kr[it]; *(LAS v4u*)(F.lds + V_OFF + o) = vr[it]; }
}
struct KVR { v4u k[8], v[8]; };
__device__ __forceinline__ void kv_issue(KVR& R, int tid, const bf16* kbase, const bf16* vbase, size_t rstride, int first_valid) {
#pragma unroll
    for (int it = 0; it < 8; ++it) { const int idx = tid + 512 * it, row = idx >> 4, ch = idx & 15;
        if (row >= first_valid) { R.k[it] = *(const GAS v4u*)(kbase + (size_t)row * rstride + ch * 8); R.v[it] = *(const GAS v4u*)(vbase + (size_t)row * rstride + ch * 8); }
        else { R.k[it] = (v4u){0u, 0u, 0u, 0u}; R.v[it] = (v4u){0u, 0u, 0u, 0u}; } }
}
__device__ __forceinline__ void kv_commit(Frame& F, const KVR& R) {
#pragma unroll
    for (int it = 0; it < 8; ++it) { const int idx = F.tid + 512 * it, row = idx >> 4, ch = idx & 15; const unsigned o = offb(row, ch);
        *(LAS v4u*)(F.lds + K_OFF + o) = R.k[it]; *(LAS v4u*)(F.lds + V_OFF + o) = R.v[it]; }
}
struct KVH { v4u k[4], v[4]; };
__device__ __forceinline__ void kvh_issue(KVH& R, int tid, const bf16* kbase, const bf16* vbase, size_t rstride, bool zero) {
#pragma unroll
    for (int it = 0; it < 4; ++it) { const int idx = tid + 512 * it, row = idx >> 4, ch = idx & 15;
        if (!zero) { R.k[it] = *(const GAS v4u*)(kbase + (size_t)row * rstride + ch * 8); R.v[it] = *(const GAS v4u*)(vbase + (size_t)row * rstride + ch * 8); }
        else { R.k[it] = (v4u){0u, 0u, 0u, 0u}; R.v[it] = (v4u){0u, 0u, 0u, 0u}; } }
}
__device__ __forceinline__ void kvh_commit(Frame& F, const KVH& R, int half) {
#pragma unroll
    for (int it = 0; it < 4; ++it) { const int idx = F.tid + 512 * it, row = 128 * half + (idx >> 4), ch = idx & 15; const unsigned o = offb(row, ch);
        *(LAS v4u*)(F.lds + K_OFF + o) = R.k[it]; *(LAS v4u*)(F.lds + V_OFF + o) = R.v[it]; }
}
template <bool CONSTB, class Idx>
__device__ __forceinline__ void attn_pairs(Frame& F, const LAS float* lut, float cbias, const bf16x8 (&qf)[4], int jp0, int npairs, const Idx& idx, f32x4 (&o)[8], float& l, int jx = 0) {
    const int fr = F.lane & 15, fq = F.lane >> 4;
    const int kp = 8 * (fq & 1) + 4 * (fq >> 1);
    const int pr = 8 * ((fr >> 2) & 1) + 4 * (fr >> 3) + (fr & 3);
    const int tq = fr >> 2, tp = fr & 3;
    const LAS unsigned char* kbase = F.lds + K_OFF; const LAS unsigned char* vbase = F.lds + V_OFF;
    const int jlast = jp0 + npairs - 1;
    bf16x8 ka[4], kb[4];
#pragma unroll
    for (int s = 0; s < 4; ++s) { ka[s] = *(const LAS bf16x8*)(kbase + offb(32 * (jp0 ^ jx) + pr, 4 * s + fq)); kb[s] = *(const LAS bf16x8*)(kbase + offb(32 * (jp0 ^ jx) + 16 + pr, 4 * s + fq)); }
#pragma unroll 1
    for (int jp = jp0; jp <= jlast; ++jp) {
        const int ja = 2 * jp, jb = ja + 1;
        const int pa = 2 * (jp ^ jx), pb = pa + 1;
        int ix[8]; float lv[8];
        if (!CONSTB) {
#pragma unroll
            for (int i = 0; i < 4; ++i) { ix[i] = idx(16 * ja + kp + i); ix[4 + i] = idx(16 * jb + kp + i); }
#pragma unroll
            for (int i = 0; i < 8; ++i) lv[i] = lut[ix[i] < 0 ? 0 : ix[i]];
        }
        s16x4 va[4], vb[4], vc[4], vd[4];
#pragma unroll
        for (int dt = 0; dt < 4; ++dt) {
            va[dt] = __builtin_amdgcn_ds_read_tr16_b64_v4i16((LAS s16x4*)(vbase + offb(16 * pa + kp + tq, 2 * dt + (tp >> 1)) + 8 * (tp & 1)));
            vb[dt] = __builtin_amdgcn_ds_read_tr16_b64_v4i16((LAS s16x4*)(vbase + offb(16 * pb + kp + tq, 2 * dt + (tp >> 1)) + 8 * (tp & 1)));
        }
        f32x4 sa = {0.f, 0.f, 0.f, 0.f}, sb = {0.f, 0.f, 0.f, 0.f};
#pragma unroll
        for (int s = 0; s < 4; ++s) {
            sa = __builtin_amdgcn_mfma_f32_16x16x32_bf16(ka[s], qf[s], sa, 0, 0, 0);
            sb = __builtin_amdgcn_mfma_f32_16x16x32_bf16(kb[s], qf[s], sb, 0, 0, 0);
        }
        __builtin_amdgcn_sched_barrier(0);
        const int jn = (jp < jlast ? jp + 1 : jlast) ^ jx;
#pragma unroll
        for (int s = 0; s < 4; ++s) { ka[s] = *(const LAS bf16x8*)(kbase + offb(32 * jn + pr, 4 * s + fq)); kb[s] = *(const LAS bf16x8*)(kbase + offb(32 * jn + 16 + pr, 4 * s + fq)); }
        float p[8];
#pragma unroll
        for (int i = 0; i < 4; ++i) {
            if (CONSTB) { p[i] = __builtin_amdgcn_exp2f(sa[i] + cbias); p[4 + i] = __builtin_amdgcn_exp2f(sb[i] + cbias); }
            else { const float ea = __builtin_amdgcn_exp2f(sa[i] + lv[i]), eb = __builtin_amdgcn_exp2f(sb[i] + lv[4 + i]); p[i] = ix[i] < 0 ? 0.f : ea; p[4 + i] = ix[4 + i] < 0 ? 0.f : eb; }
        }
        l += ((p[0] + p[1]) + (p[2] + p[3])) + ((p[4] + p[5]) + (p[6] + p[7]));
        v4u pw; pw.x = pkbf(p[0], p[1]); pw.y = pkbf(p[2], p[3]); pw.z = pkbf(p[4], p[5]); pw.w = pkbf(p[6], p[7]);
        const bf16x8 pf = __builtin_bit_cast(bf16x8, pw);
#pragma unroll
        for (int dt = 0; dt < 4; ++dt) {
            vc[dt] = __builtin_amdgcn_ds_read_tr16_b64_v4i16((LAS s16x4*)(vbase + offb(16 * pa + kp + tq, 2 * (dt + 4) + (tp >> 1)) + 8 * (tp & 1)));
            vd[dt] = __builtin_amdgcn_ds_read_tr16_b64_v4i16((LAS s16x4*)(vbase + offb(16 * pb + kp + tq, 2 * (dt + 4) + (tp >> 1)) + 8 * (tp & 1)));
        }
#pragma unroll
        for (int dt = 0; dt < 4; ++dt) {
            const bf16x8 vf = __builtin_shufflevector(va[dt], vb[dt], 0, 1, 2, 3, 4, 5, 6, 7);
            o[dt] = __builtin_amdgcn_mfma_f32_16x16x32_bf16(vf, pf, o[dt], 0, 0, 0);
        }
#pragma unroll
        for (int dt = 0; dt < 4; ++dt) {
            const bf16x8 vf = __builtin_shufflevector(vc[dt], vd[dt], 0, 1, 2, 3, 4, 5, 6, 7);
            o[dt + 4] = __builtin_amdgcn_mfma_f32_16x16x32_bf16(vf, pf, o[dt + 4], 0, 0, 0);
        }
    }
}
constexpr float RL_NEG = -1.0e30f;
__device__ __forceinline__ void attn_pairs_rl(Frame& F, const LAS float* rlp, const bf16x8 (&qf)[4], int jp0, int npairs, f32x4 (&o)[8], float& l, int jx = 0) {
    const int fr = F.lane & 15, fq = F.lane >> 4;
    const int kp = 8 * (fq & 1) + 4 * (fq >> 1);
    const int pr = 8 * ((fr >> 2) & 1) + 4 * (fr >> 3) + (fr & 3);
    const int tq = fr >> 2, tp = fr & 3;
    const LAS unsigned char* kbase = F.lds + K_OFF; const LAS unsigned char* vbase = F.lds + V_OFF;
    const int jlast = jp0 + npairs - 1;
    bf16x8 ka[4], kb[4];
#pragma unroll
    for (int s = 0; s < 4; ++s) { ka[s] = *(const LAS bf16x8*)(kbase + offb(32 * (jp0 ^ jx) + pr, 4 * s + fq)); kb[s] = *(const LAS bf16x8*)(kbase + offb(32 * (jp0 ^ jx) + 16 + pr, 4 * s + fq)); }
    f32x4 la, lb;
    { const LAS float* rp = rlp + 32 * jp0;
#pragma unroll
      for (int i = 0; i < 4; ++i) { la[i] = rp[i]; lb[i] = rp[16 + i]; } }
#pragma unroll 1
    for (int jp = jp0; jp <= jlast; ++jp) {
        const int pa = 2 * (jp ^ jx), pb = pa + 1;
        s16x4 va[4], vb[4], vc[4], vd[4];
#pragma unroll
        for (int dt = 0; dt < 4; ++dt) {
            va[dt] = __builtin_amdgcn_ds_read_tr16_b64_v4i16((LAS s16x4*)(vbase + offb(16 * pa + kp + tq, 2 * dt + (tp >> 1)) + 8 * (tp & 1)));
            vb[dt] = __builtin_amdgcn_ds_read_tr16_b64_v4i16((LAS s16x4*)(vbase + offb(16 * pb + kp + tq, 2 * dt + (tp >> 1)) + 8 * (tp & 1)));
        }
        f32x4 sa = la, sb = lb;
#pragma unroll
        for (int s = 0; s < 4; ++s) {
            sa = __builtin_amdgcn_mfma_f32_16x16x32_bf16(ka[s], qf[s], sa, 0, 0, 0);
            sb = __builtin_amdgcn_mfma_f32_16x16x32_bf16(kb[s], qf[s], sb, 0, 0, 0);
        }
        __builtin_amdgcn_sched_barrier(0);
        const int jl = jp < jlast ? jp + 1 : jlast, jn = jl ^ jx;
#pragma unroll
        for (int s = 0; s < 4; ++s) { ka[s] = *(const LAS bf16x8*)(kbase + offb(32 * jn + pr, 4 * s + fq)); kb[s] = *(const LAS bf16x8*)(kbase + offb(32 * jn + 16 + pr, 4 * s + fq)); }
        { const LAS float* rp = rlp + 32 * jl;
#pragma unroll
          for (int i = 0; i < 4; ++i) { la[i] = rp[i]; lb[i] = rp[16 + i]; } }
        float p[8];
#pragma unroll
        for (int i = 0; i < 4; ++i) { p[i] = __builtin_amdgcn_exp2f(sa[i]); p[4 + i] = __builtin_amdgcn_exp2f(sb[i]); }
        l += ((p[0] + p[1]) + (p[2] + p[3])) + ((p[4] + p[5]) + (p[6] + p[7]));
        v4u pw; pw.x = pkbf(p[0], p[1]); pw.y = pkbf(p[2], p[3]); pw.z = pkbf(p[4], p[5]); pw.w = pkbf(p[6], p[7]);
        const bf16x8 pf = __builtin_bit_cast(bf16x8, pw);
#pragma unroll
        for (int dt = 0; dt < 4; ++dt) {
            vc[dt] = __builtin_amdgcn_ds_read_tr16_b64_v4i16((LAS s16x4*)(vbase + offb(16 * pa + kp + tq, 2 * (dt + 4) + (tp >> 1)) + 8 * (tp & 1)));
            vd[dt] = __builtin_amdgcn_ds_read_tr16_b64_v4i16((LAS s16x4*)(vbase + offb(16 * pb + kp + tq, 2 * (dt + 4) + (tp >> 1)) + 8 * (tp & 1)));
        }
#pragma unroll
        for (int dt = 0; dt < 4; ++dt) {
            const bf16x8 vf = __builtin_shufflevector(va[dt], vb[dt], 0, 1, 2, 3, 4, 5, 6, 7);
            o[dt] = __builtin_amdgcn_mfma_f32_16x16x32_bf16(vf, pf, o[dt], 0, 0, 0);
        }
#pragma unroll
        for (int dt = 0; dt < 4; ++dt) {
            const bf16x8 vf = __builtin_shufflevector(vc[dt], vd[dt], 0, 1, 2, 3, 4, 5, 6, 7);
            o[dt + 4] = __builtin_amdgcn_mfma_f32_16x16x32_bf16(vf, pf, o[dt + 4], 0, 0, 0);
        }
    }
}
__device__ __forceinline__ void o_tile_pack(const f32x4 (&o)[8], float sc, int fq, v4u (&w)[4]) {
    const bool odd = (fq & 1) != 0;
#pragma unroll
    for (int p = 0; p < 4; ++p) {
        const unsigned a0 = pkbf(o[2 * p][0] * sc, o[2 * p][1] * sc), a1 = pkbf(o[2 * p][2] * sc, o[2 * p][3] * sc);
        const unsigned b0 = pkbf(o[2 * p + 1][0] * sc, o[2 * p + 1][1] * sc), b1 = pkbf(o[2 * p + 1][2] * sc, o[2 * p + 1][3] * sc);
        const unsigned s0 = odd ? a0 : b0, s1 = odd ? a1 : b1;
        const unsigned r0 = (unsigned)xshf_i<16>((int)s0), r1 = (unsigned)xshf_i<16>((int)s1);
        w[p] = odd ? (v4u){r0, r1, b0, b1} : (v4u){a0, a1, r0, r1};
    }
}
__device__ __forceinline__ int o_tile_off(int fq, int p) { return 32 * p + ((fq & 1) ? 16 + 4 * (fq - 1) : 4 * fq); }
__device__ __forceinline__ void load_qf(const bf16* qrow, int fq, bf16x8 (&qf)[4]) {
#pragma unroll
    for (int s = 0; s < 4; ++s) qf[s] = *(const GAS bf16x8*)(qrow + 32 * s + 8 * fq);
}

__device__ __forceinline__ const bf16* hm_row(const Frame& F, int slot, long t) { return (const bf16*)(F.ws + WS_PROJ) + ((size_t)slot * S + t) * HD; }
__device__ __forceinline__ void load_bias_table(Frame& F, float M2) {
    LAS float* bt = (LAS float*)(F.lds + BIAS_OFF);
    for (int i = F.tid; i < 32 * NH; i += 512) bt[i] = INP(1)[i] * LOG2E - M2;
}
__device__ __forceinline__ void p_dilated(Frame& F) {
    const float M2 = softmax_offset(F, INP(5), 3 * HD, INP(6), HD);
    LAS float* lut = (LAS float*)(F.lds + X_OFF);
    const LAS float* bt = (const LAS float*)(F.lds + BIAS_OFF);
    load_bias_table(F, M2);
    __syncthreads();
    const int fr = F.lane & 15, fq = F.lane >> 4, w = F.wave;
    for (int p = F.vcu; p < 8 * NH; p += F.G) {
        const int h = p >> 3, i = p & 7;
#pragma unroll 1
        for (int cc = 0; cc < 4; ++cc) {
            const int g = cc < 2 ? cc : 2, dsh = 2 * g;
            const int r = cc == 0 ? 0 : (cc == 1 ? (i >> 1) : 2 * i + (cc - 2));
            const int b0 = cc == 0 ? 8 * i : (cc == 1 ? 8 * (i & 1) : 0), nblk = cc < 2 ? 8 : 4;
            const size_t rstride = (size_t)HD << dsh;
            const int kslot = 96 + h, vslot = 128 + h, qslot = 32 * g + h;
            KVH A, B;
            kvh_issue(A, F.tid, hm_row(F, kslot, ((long)(128 * b0) << dsh) + r), hm_row(F, vslot, ((long)(128 * b0) << dsh) + r), rstride, false);
            kvh_issue(B, F.tid, hm_row(F, kslot, ((long)(128 * (b0 - 1)) << dsh) + r), hm_row(F, vslot, ((long)(128 * (b0 - 1)) << dsh) + r), rstride, b0 == 0);
            bf16x8 qn[4]; load_qf(hm_row(F, qslot, ((long)(128 * b0 + 16 * w + fr) << dsh) + r), fq, qn);
            __syncthreads();
            kvh_commit(F, A, 0); kvh_commit(F, B, 1);
            if (F.tid < 384) { const int dist = 255 - F.tid; lut[F.tid] = (dist >= 0 && dist <= 128) ? bt[t5_bucket(dist << dsh) * NH + h] : RL_NEG; }
#pragma unroll 1
            for (int b = b0; b < b0 + nblk; ++b) {
                __syncthreads();
                const bool more = b + 1 < b0 + nblk;
                if (more) kvh_issue(A, F.tid, hm_row(F, kslot, ((long)(128 * (b + 1)) << dsh) + r), hm_row(F, vslot, ((long)(128 * (b + 1)) << dsh) + r), rstride, false);
                bf16x8 qf[4];
#pragma unroll
                for (int s = 0; s < 4; ++s) qf[s] = qn[s];
                if (more) load_qf(hm_row(F, qslot, ((long)(128 * (b + 1) + 16 * w + fr) << dsh) + r), fq, qn);
                const int iq = 16 * w + fr;
                const long tq = ((long)(128 * b + iq) << dsh) + r;
                f32x4 o[8];
#pragma unroll
                for (int dt = 0; dt < 8; ++dt) o[dt] = (f32x4){0.f, 0.f, 0.f, 0.f};
                float l = 0.f;
                const int jp0 = (b == 0) ? 4 : (w >> 1);
                attn_pairs_rl(F, lut + (127 - iq + 8 * (fq & 1) + 4 * (fq >> 1)), qf, jp0, (w >> 1) + 5 - jp0, o, l, (b & 1) ? 0 : 4);
                l += xshf<16>(l); l += xshf<32>(l);
                bf16* po = ((bf16*)(F.ws + (WS_PART))) + ((size_t)(g * NH + h) * S + tq) * HD;
                { v4u wv[4]; o_tile_pack(o, 1.0f, fq, wv);
#pragma unroll
                  for (int pp = 0; pp < 4; ++pp) *(GAS v4u*)(po + o_tile_off(fq, pp)) = wv[pp]; }
                if (fq == 0) ((float*)(F.ws + (WS_LPART)))[(size_t)(g * NH + h) * S + tq] = l;
                if (more) { __syncthreads();
                    kvh_commit(F, A, (b + 1) & 1); }
            }
        }
    }
    __syncthreads();
}
__device__ __forceinline__ void p_merge3(Frame& F) {
    const size_t n8 = (size_t)S * D / 8;
    const bf16* part = (const bf16*)(F.ws + WS_PART); const float* lp = (const float*)(F.ws + WS_LPART);
    for (size_t i = (size_t)F.vcu * 512 + F.tid; i < n8; i += (size_t)F.G * 512) {
        const size_t ht = i >> 4;
        const float L = lp[ht] + lp[(size_t)NH * S + ht] + lp[(size_t)2 * NH * S + ht];
        const float inv = 1.0f / L;
        const v4u a = *(const GAS v4u*)(part + i * 8), b = *(const GAS v4u*)(part + (size_t)S * D + i * 8), c = *(const GAS v4u*)(part + (size_t)2 * S * D + i * 8);
        v4u o;
        o.x = pkbf((bflo(a.x) + bflo(b.x) + bflo(c.x)) * inv, (bfhi(a.x) + bfhi(b.x) + bfhi(c.x)) * inv);
        o.y = pkbf((bflo(a.y) + bflo(b.y) + bflo(c.y)) * inv, (bfhi(a.y) + bfhi(b.y) + bfhi(c.y)) * inv);
        o.z = pkbf((bflo(a.z) + bflo(b.z) + bflo(c.z)) * inv, (bfhi(a.z) + bfhi(b.z) + bfhi(c.z)) * inv);
        o.w = pkbf((bflo(a.w) + bflo(b.w) + bflo(c.w)) * inv, (bfhi(a.w) + bfhi(b.w) + bfhi(c.w)) * inv);
        *(GAS v4u*)(((bf16*)(F.ws + (WS_OB))) + i * 8) = o;
    }
}
__device__ __forceinline__ void top3_insert(float v, unsigned i, float& v0, float& v1, float& v2, unsigned& i0, unsigned& i1, unsigned& i2) {
    const bool g0 = v > v0 || (v == v0 && i < i0), g1 = v > v1 || (v == v1 && i < i1), g2 = v > v2 || (v == v2 && i < i2);
    const float n2 = g1 ? v1 : (g2 ? v : v2), n1 = g0 ? v0 : (g1 ? v : v1), n0 = g0 ? v : v0;
    const unsigned j2 = g1 ? i1 : (g2 ? i : i2), j1 = g0 ? i0 : (g1 ? i : i1), j0 = g0 ? i : i0;
    v0 = n0; v1 = n1; v2 = n2; i0 = j0; i1 = j1; i2 = j2;
}
__device__ __forceinline__ void p_gate(Frame& F) {
    constexpr int KH_OFF = 0, KL_OFF = 8192;
    const int fr = F.lane & 15, fq = F.lane >> 4, w = F.wave;
    const float NEGV = -3.0e38f;
    constexpr int NU = 32 * NH;
    int hcur = -1;
    bf16x8 hf[2][4], lf[2][4];
    int u = F.vcu;
    bf16x8 qn[4];
    if (u < NU) load_qf(hm_row(F, 64 + u % NH, 256 * (u / NH) + 32 * w + fr), fq, qn);
    for (int st = 0; u < NU; ++st) {
        const int c = u / NH, h = u % NH, qt = st & 1;
        if (h != hcur) {
            __syncthreads();
            { const int n = F.tid >> 4, ch = F.tid & 15;
              const GAS f32x4* src = (const GAS f32x4*)(((float*)(F.ws + (WS_KMEAN))) + (size_t)n * D + h * HD + 8 * ch);
              const f32x4 a = src[0], b = src[1];
              unsigned hi[4], lo[4];
              hi[0] = pkbf(a[0], a[1]); hi[1] = pkbf(a[2], a[3]); hi[2] = pkbf(b[0], b[1]); hi[3] = pkbf(b[2], b[3]);
              lo[0] = pkbf(a[0] - bflo(hi[0]), a[1] - bfhi(hi[0])); lo[1] = pkbf(a[2] - bflo(hi[1]), a[3] - bfhi(hi[1]));
              lo[2] = pkbf(b[0] - bflo(hi[2]), b[1] - bfhi(hi[2])); lo[3] = pkbf(b[2] - bflo(hi[3]), b[3] - bfhi(hi[3]));
              const unsigned o = offb(n, ch);
              *(LAS v4u*)(F.lds + KH_OFF + o) = (v4u){hi[0], hi[1], hi[2], hi[3]}; *(LAS v4u*)(F.lds + KL_OFF + o) = (v4u){lo[0], lo[1], lo[2], lo[3]}; }
            __syncthreads();
#pragma unroll
            for (int s = 0; s < 4; ++s) {
                hf[0][s] = *(const LAS bf16x8*)(F.lds + KH_OFF + offb(fr, 4 * s + fq)); hf[1][s] = *(const LAS bf16x8*)(F.lds + KH_OFF + offb(16 + fr, 4 * s + fq));
                lf[0][s] = *(const LAS bf16x8*)(F.lds + KL_OFF + offb(fr, 4 * s + fq)); lf[1][s] = *(const LAS bf16x8*)(F.lds + KL_OFF + offb(16 + fr, 4 * s + fq)); }
            hcur = h;
        }
        const int t = 256 * c + 32 * w + 16 * qt + fr;
        bf16x8 qf[4];
#pragma unroll
        for (int s = 0; s < 4; ++s) qf[s] = qn[s];
        const int un = qt ? u + F.G : u;
        if (un < NU) load_qf(hm_row(F, 64 + un % NH, 256 * (un / NH) + 32 * w + 16 * (qt ^ 1) + fr), fq, qn);
        f32x4 g0 = {0.f, 0.f, 0.f, 0.f}, g1 = {0.f, 0.f, 0.f, 0.f};
#pragma unroll
        for (int s = 0; s < 4; ++s) {
            g0 = __builtin_amdgcn_mfma_f32_16x16x32_bf16(hf[0][s], qf[s], g0, 0, 0, 0); g0 = __builtin_amdgcn_mfma_f32_16x16x32_bf16(lf[0][s], qf[s], g0, 0, 0, 0);
            g1 = __builtin_amdgcn_mfma_f32_16x16x32_bf16(hf[1][s], qf[s], g1, 0, 0, 0); g1 = __builtin_amdgcn_mfma_f32_16x16x32_bf16(lf[1][s], qf[s], g1, 0, 0, 0);
        }
        float v0 = NEGV, v1 = NEGV, v2 = NEGV; unsigned i0 = 0xffu, i1 = 0xffu, i2 = 0xffu;
#pragma unroll
        for (int i = 0; i < 4; ++i) { const int na = 4 * fq + i, nb = 16 + 4 * fq + i;
            top3_insert(na < c ? g0[i] : NEGV, na < c ? (unsigned)na : 0xffu, v0, v1, v2, i0, i1, i2);
            top3_insert(nb < c ? g1[i] : NEGV, nb < c ? (unsigned)nb : 0xffu, v0, v1, v2, i0, i1, i2); }
#define GATE_MERGE(M) { const float pv0 = xshf<M>(v0), pv1 = xshf<M>(v1), pv2 = xshf<M>(v2); \
            const unsigned pi0 = (unsigned)xshf_i<M>((int)i0), pi1 = (unsigned)xshf_i<M>((int)i1), pi2 = (unsigned)xshf_i<M>((int)i2); \
            top3_insert(pv0, pi0, v0, v1, v2, i0, i1, i2); top3_insert(pv1, pi1, v0, v1, v2, i0, i1, i2); top3_insert(pv2, pi2, v0, v1, v2, i0, i1, i2); }
        GATE_MERGE(16) GATE_MERGE(32)
#undef GATE_MERGE
        if (fq == 0) ((unsigned*)(F.ws + (WS_SEL)))[(size_t)h * S + t] = i0 | (i1 << 8) | (i2 << 16) | 0xff000000u;
        u = un;
    }
    __syncthreads();
}
__constant__ unsigned char PB_ITEMS[54][3] = {{7,8,20},{0,3,7},{2,3,7},{9,10,25},{1,5,12},{4,5,12},{0,7,17},{2,7,17},{6,7,17},{3,9,22},{8,9,22},{10,11,27},{1,2,5},{5,6,14},{3,4,9},{1,12,28},{4,12,28},{11,12,28},{12,13,29},{5,14,30},{13,14,30},{14,15,31},{15,16,32},{0,1,3},{0,17,32},{2,17,32},{6,17,32},{16,17,32},{17,18,32},{18,19,32},{7,20,32},{19,20,32},{20,21,32},{3,22,32},{8,22,32},{21,22,32},{22,23,32},{23,24,32},{9,25,32},{24,25,32},{25,26,32},{10,27,32},{26,27,32},{1,28,32},{4,28,32},{11,28,32},{27,28,32},{12,29,32},{28,29,32},{5,30,32},{13,30,32},{29,30,32},{14,31,32},{30,31,32}};
__constant__ unsigned char PB_CLASS[8][7] = {{0,17,16,31,35,45,51},{2,13,18,29,33,43,255},{1,14,15,30,34,44,49},{3,12,22,26,36,46,47},{5,9,23,27,32,48,53},{4,11,21,25,39,40,255},{8,6,19,28,37,42,50},{7,10,20,24,38,41,52}};
constexpr int N_PB = 54, PB_NSEL = 8;
__device__ __forceinline__ void build_lut_moba(Frame& F, int h, int n) {
    LAS float* lut = (LAS float*)(F.lds + X_OFF);
    const LAS float* bt = (const LAS float*)(F.lds + BIAS_OFF);
    for (int i = F.tid; i < n; i += 512) lut[i] = bt[t5_bucket(i) * NH + h];
}
constexpr int RL_CP = 1791;
__device__ __forceinline__ void build_rl_own(Frame& F, int h) {
    LAS float* rl = (LAS float*)(F.lds + X_OFF);
    const LAS float* bt = (const LAS float*)(F.lds + BIAS_OFF);
    { const int i = F.tid, dist = 255 - i; rl[i] = dist >= 0 ? bt[t5_bucket(dist) * NH + h] : RL_NEG; }
}
__device__ __forceinline__ void build_rl_past(Frame& F, int h) {
    LAS float* rl = (LAS float*)(F.lds + X_OFF);
    const LAS float* bt = (const LAS float*)(F.lds + BIAS_OFF);
    for (int i = F.tid; i < 2048; i += 512) { const int dist = RL_CP - i; rl[i] = bt[t5_bucket(dist < 0 ? 0 : dist) * NH + h]; }
}
struct PbItem { int h, n, c_lo, c_hi; };
__device__ __forceinline__ PbItem pb_decode(int it) { PbItem x; const int k = it / NH; x.h = it % NH; x.n = PB_ITEMS[k][0]; x.c_lo = PB_ITEMS[k][1]; x.c_hi = PB_ITEMS[k][2]; return x; }
__device__ __forceinline__ void pb_issue(Frame& F, const PbItem& x, KVR& R) {
    kv_issue(R, F.tid, hm_row(F, x.h, 256 * x.n), hm_row(F, 32 + x.h, 256 * x.n), (size_t)HD, 0);
}
__device__ __forceinline__ void pb_sel(Frame& F, const PbItem& x, unsigned (&selr)[PB_NSEL]) {
    const int ncand = 256 * (x.c_hi - x.c_lo);
#pragma unroll
    for (int k = 0; k < PB_NSEL; ++k) { const int i = F.tid + 512 * k; selr[k] = i < ncand ? ((const unsigned*)(F.ws + WS_SEL))[(size_t)x.h * S + 256 * x.c_lo + i] : 0xffffffffu; }
}
template <int VAR>
__device__ __forceinline__ void p_past(Frame& F) {
    const float M2 = softmax_offset(F, INP(12), HD, INP(10), HD);
    LAS float* lut = (LAS float*)(F.lds + X_OFF);
    LAS unsigned short* list = (LAS unsigned short*)(F.lds + LIST_OFF);
    LAS unsigned* cntp = (LAS unsigned*)(F.lds + LDSCTL_OFF);
    const int fr = F.lane & 15, fq = F.lane >> 4;
    constexpr int NI = N_PB * NH;
    const bool packed = (F.G == 256);
    auto item_at = [&](int j) -> int { if (!packed) { const int i = F.vcu + j * F.G; return i < NI ? i : -1; }
        if (j >= 7) return -1; const int k = PB_CLASS[F.vcu >> 5][j]; return k == 255 ? -1 : k * NH + (F.vcu & 31); };
    int js = 0; int it = item_at(0);
    load_bias_table(F, M2);
    __syncthreads();
    build_rl_past(F, F.vcu % NH);
    const LAS float* btc = (const LAS float*)(F.lds + BIAS_OFF);
    KVR R;
    if (it >= 0) pb_issue(F, pb_decode(it), R);
    for (; it >= 0; it = item_at(++js)) {
        const PbItem x = pb_decode(it);
        const int h = x.h, n = x.n;
        unsigned selr[PB_NSEL]; pb_sel(F, x, selr);
        if (F.tid == 0) *cntp = 0u;
        kv_commit(F, R);
        if (h != F.vcu % NH) build_rl_past(F, h);
        __syncthreads();
        const int ncand = 256 * (x.c_hi - x.c_lo);
#pragma unroll
        for (int k = 0; k < PB_NSEL; ++k) {
            if (512 * k < ncand) {
                const int i = F.tid + 512 * k; const unsigned s = selr[k];
                const int slot = (i >= ncand) ? -1 : (((s & 0xffu) == (unsigned)n) ? 0 : ((((s >> 8) & 0xffu) == (unsigned)n) ? 1 : ((((s >> 16) & 0xffu) == (unsigned)n) ? 2 : -1)));
                const unsigned long long mask = __ballot(slot >= 0);
                unsigned base = 0u;
                if (F.lane == 0 && mask != 0ull) base = __hip_atomic_fetch_add(cntp, (unsigned)__popcll(mask), __ATOMIC_RELAXED, __HIP_MEMORY_SCOPE_WORKGROUP);
                base = (unsigned)__builtin_amdgcn_readfirstlane((int)base);
                if (slot >= 0) list[base + (unsigned)__popcll(mask & ((1ull << F.lane) - 1ull))] = (unsigned short)((unsigned)i | ((unsigned)slot << 13));
            }
        }
        __syncthreads();
        const int cnt = (int)*cntp, ntile = (cnt + 15) >> 4;
        int ti = F.wave;
        unsigned entn = 0u; bf16x8 qn[4];
        const int tb0 = 256 * x.c_lo;
        if (ti < ntile) { const int e = 16 * ti + fr; entn = list[e < cnt ? e : 0]; load_qf(hm_row(F, 64 + h, (long)(tb0 + (int)(entn & 0x1fffu))), fq, qn); }
        while (ti < ntile) {
            const unsigned ent = entn; const bool valid = (16 * ti + fr) < cnt;
            bf16x8 qf[4];
#pragma unroll
            for (int s = 0; s < 4; ++s) qf[s] = qn[s];
            const int tn = ti + NWAVES;
            if (tn < ntile) { const int e = 16 * tn + fr; entn = list[e < cnt ? e : 0]; load_qf(hm_row(F, 64 + h, (long)(tb0 + (int)(entn & 0x1fffu))), fq, qn); }
            const int t = tb0 + (int)(ent & 0x1fffu), slot = (int)(ent >> 13);
            f32x4 o[8];
#pragma unroll
            for (int dt = 0; dt < 8; ++dt) o[dt] = (f32x4){0.f, 0.f, 0.f, 0.f};
            float l = 0.f;
            const int tbase = t - 256 * n;
            if (VAR != 3) { const int jb = RL_CP - tbase; attn_pairs_rl(F, lut + ((jb < 0 ? 0 : jb) + 8 * (fq & 1) + 4 * (fq >> 1)), qf, 0, 8, o, l); }
            else { l = __builtin_bit_cast(float, (int)qf[0][0] + (int)qf[1][1] + (int)qf[2][2] + (int)qf[3][3]); }
            l += xshf<16>(l); l += xshf<32>(l);
            if (valid && (VAR != 2 || l == 12345.678f)) {
                int fqo = fq; asm volatile("" : "+v"(fqo));
                const float invl = 1.0f / l;
                v4u wa, wb;
                { int q0 = 0, q1 = 0, q2 = 0, q3 = 0, q4 = 0, q5 = 0, q6 = 0, q7 = 0;
#define FP8_DW(q, dt) q = __builtin_amdgcn_cvt_pk_fp8_f32(o[dt][0] * invl, o[dt][1] * invl, q, false); q = __builtin_amdgcn_cvt_pk_fp8_f32(o[dt][2] * invl, o[dt][3] * invl, q, true);
                  FP8_DW(q0, 0) FP8_DW(q1, 1) FP8_DW(q2, 2) FP8_DW(q3, 3) FP8_DW(q4, 4) FP8_DW(q5, 5) FP8_DW(q6, 6) FP8_DW(q7, 7)
#undef FP8_DW
                  wa = (v4u){(unsigned)q0, (unsigned)q1, (unsigned)q2, (unsigned)q3}; wb = (v4u){(unsigned)q4, (unsigned)q5, (unsigned)q6, (unsigned)q7}; }
                unsigned char* po = (unsigned char*)(F.ws + WS_PART) + ((size_t)(slot * NH + h) * S + t) * 128 + 32 * fqo;
                *(GAS v4u*)(po) = wa; *(GAS v4u*)(po + 16) = wb;
                if (fq == 0) ((float*)(F.ws + (WS_LPART)))[(size_t)(slot * NH + h) * S + t] = l;
            }
            ti = tn;
        }
        { const int itn = item_at(js + 1); if (itn >= 0) pb_issue(F, pb_decode(itn), R); }
        __syncthreads();
    }
}
__device__ __forceinline__ void own_issue(Frame& F, int u, KVR& R) {
    const int c = u / NH, h = u % NH;
    kv_issue(R, F.tid, hm_row(F, h, 256 * c), hm_row(F, 32 + h, 256 * c), (size_t)HD, 0);
}
__device__ __forceinline__ void p_own(Frame& F) {
    const float M2 = softmax_offset(F, INP(12), HD, INP(10), HD);
    LAS float* lut = (LAS float*)(F.lds + X_OFF);
    const int fr = F.lane & 15, fq = F.lane >> 4, w = F.wave;
    constexpr int NU = 32 * NH;
    int u = F.vcu;
    load_bias_table(F, M2);
    __syncthreads();
    build_rl_own(F, F.vcu % NH);
    KVR R;
    if (u < NU) own_issue(F, u, R);
    for (; u < NU; u += F.G) {
        const int c = u / NH, h = u % NH;
        kv_commit(F, R);
        if (h != F.vcu % NH) build_rl_own(F, h);
        __syncthreads();
        const int nslot = c < 3 ? c : 3;
        bf16x8 qa[4], qbf[4];
        load_qf(hm_row(F, 64 + h, 256 * c + 16 * w + fr), fq, qa);
#pragma unroll
        for (int pass = 0; pass < 2; ++pass) {
            const int qt = pass == 0 ? w : 15 - w, iq = 16 * qt + fr, t = 256 * c + iq;
            f32x4 o[8];
#pragma unroll
            for (int dt = 0; dt < 8; ++dt) o[dt] = (f32x4){0.f, 0.f, 0.f, 0.f};
            float l = 0.f;
            const LAS float* rlp = lut + (255 - iq + 8 * (fq & 1) + 4 * (fq >> 1));
            if (pass == 0) attn_pairs_rl(F, rlp, qa, 0, (qt >> 1) + 1, o, l); else attn_pairs_rl(F, rlp, qbf, 0, (qt >> 1) + 1, o, l);
            l += xshf<16>(l); l += xshf<32>(l);
            if (pass == 0) load_qf(hm_row(F, 64 + h, 256 * c + 16 * (15 - w) + fr), fq, qbf);
            v4u pa[3], pb[3]; float lp[3];
#pragma unroll
            for (int s = 0; s < 3; ++s) {
                if (s < nslot) { lp[s] = ((const float*)(F.ws + WS_LPART))[(size_t)(s * NH + h) * S + t];
                    const unsigned char* p = (const unsigned char*)(F.ws + WS_PART) + ((size_t)(s * NH + h) * S + t) * 128 + 32 * fq;
                    pa[s] = *(const GAS v4u*)(p); pb[s] = *(const GAS v4u*)(p + 16); }
                else { lp[s] = 0.f; pa[s] = (v4u){0u, 0u, 0u, 0u}; pb[s] = (v4u){0u, 0u, 0u, 0u}; }
            }
#pragma unroll
            for (int s = 0; s < 3; ++s) { l += lp[s]; const float ws = lp[s];
#define FP8_ACC(dw, dt) { const int q_ = (int)(dw); const f32x2 lo_ = __builtin_amdgcn_cvt_pk_f32_fp8(q_, false), hi_ = __builtin_amdgcn_cvt_pk_f32_fp8(q_, true); o[dt][0] += ws * lo_[0]; o[dt][1] += ws * lo_[1]; o[dt][2] += ws * hi_[0]; o[dt][3] += ws * hi_[1]; }
                FP8_ACC(pa[s].x, 0) FP8_ACC(pa[s].y, 1) FP8_ACC(pa[s].z, 2) FP8_ACC(pa[s].w, 3) FP8_ACC(pb[s].x, 4) FP8_ACC(pb[s].y, 5) FP8_ACC(pb[s].z, 6) FP8_ACC(pb[s].w, 7)
                asm volatile("" : "+v"(o[0]), "+v"(o[1]), "+v"(o[2]), "+v"(o[3]), "+v"(o[4]), "+v"(o[5]), "+v"(o[6]), "+v"(o[7]));
#undef FP8_ACC
            }
            const float inv = 1.0f / l;
            bf16* po = ((bf16*)(F.ws + (WS_OB))) + ((size_t)h * S + t) * HD;
            { v4u wv[4]; o_tile_pack(o, inv, fq, wv);
#pragma unroll
              for (int p = 0; p < 4; ++p) *(GAS v4u*)(po + o_tile_off(fq, p)) = wv[p]; }
        }
        if (u + F.G < NU) own_issue(F, u + F.G, R);
        __syncthreads();
    }
}
#ifndef EN_P0
#define EN_P0 1
#endif
#ifndef EN_P1
#define EN_P1 1
#endif
#ifndef EN_P2
#define EN_P2 1
#endif
#ifndef EN_P3
#define EN_P3 1
#endif
#ifndef EN_P8
#define EN_P8 1
#endif
#ifndef EN_P9
#define EN_P9 1
#endif
#ifndef EN_P10
#define EN_P10 1
#endif
#ifndef EN_P11
#define EN_P11 1
#endif
#ifndef EN_P12
#define EN_P12 1
#endif
#ifndef EN_PWO
#define EN_PWO 1
#endif
#ifndef EN_PN
#define EN_PN 1
#endif
#ifndef EN_PGU
#define EN_PGU 1
#endif
#ifndef EN_PDN
#define EN_PDN 1
#endif


#if defined(PROBE_GEMM) || defined(PROBE_INLINE_GEMM)
namespace pg8 {
struct EpiNull { static constexpr bool PERM = true, AFTER_DRAIN = false, INIT_BASE = false; bf16_t* O;
    __device__ __forceinline__ void operator()(const f32x4 (&acc)[2][2][4][2], const Unit& u, int wr, int wc, int fr, int fq) const {
        float s = 0.f;
#pragma unroll
        for (int ai = 0; ai < 2; ++ai)
#pragma unroll
            for (int bj = 0; bj < 2; ++bj)
#pragma unroll
                for (int m = 0; m < 4; ++m)
#pragma unroll
                    for (int n = 0; n < 2; ++n) s += acc[ai][bj][m][n][0] + acc[ai][bj][m][n][1] + acc[ai][bj][m][n][2] + acc[ai][bj][m][n][3];
        if (s == 12345.678f) O[u.pm * 7 + u.pn] = 1; } };
struct EpiPlain { static constexpr bool PERM = true, AFTER_DRAIN = false, INIT_BASE = false; bf16_t* O; int ldc;
    __device__ __forceinline__ void operator()(const f32x4 (&acc)[2][2][4][2], const Unit& u, int wr, int wc, int fr, int fq) const {
        const int row0 = u.pm * BM + wr * 64 + fr, col0 = u.pn * BM + wc * 32 + 8 * fq;
#pragma unroll
        for (int ai = 0; ai < 2; ++ai)
#pragma unroll
            for (int m = 0; m < 4; ++m) { bf16_t* rowp = O + (size_t)(row0 + ai * HALF + m * 16) * ldc + col0;
#pragma unroll
                for (int bj = 0; bj < 2; ++bj) { const f32x4 v0 = acc[ai][bj][m][0], v1 = acc[ai][bj][m][1];
                    u32x4 w; w.x = cvt_pk_bf16(v0[0], v0[1]); w.y = cvt_pk_bf16(v0[2], v0[3]); w.z = cvt_pk_bf16(v1[0], v1[1]); w.w = cvt_pk_bf16(v1[2], v1[3]);
                    *(u32x4*)(rowp + bj * HALF) = w; } } } };
}
#endif
#ifdef PROBE_GEMM
template <int V>
__global__ void __launch_bounds__(NWAVES * 64, 2) probe_gemm(Args args) {
    extern __shared__ __attribute__((aligned(16))) unsigned char lds[];
    LAS unsigned char* ring = (LAS unsigned char*)lds;
    unsigned char* ws = args.ws;
    pg8::Gemm g{(bf16*)(ws + WS_HN), (bf16*)(ws + WS_WQKV), S, NQKV, D}; pg8::StaticOrder So; So.init(S, NQKV, gridDim.x, (int)blockIdx.x);
    if (V == 0) { pg8::EpiNull E{(bf16*)(ws + WS_PROJ)}; pg8::gemm_phase<pg8::EpiNull, pg8::StaticOrder, true, true>(ring, g, So, E); }
    if (V == 1) { pg8::EpiPlain E{(bf16*)(ws + WS_PROJ), NQKV}; pg8::gemm_phase<pg8::EpiPlain, pg8::StaticOrder, true, true>(ring, g, So, E); }
    if (V == 2) { pg8::EpiNull E{(bf16*)(ws + WS_PROJ)}; pg8::gemm_phase<pg8::EpiNull, pg8::StaticOrder, false, true>(ring, g, So, E); }
    if (V == 3) { pg8::EpiPlain E{(bf16*)(ws + WS_PROJ), NQKV}; pg8::gemm_phase<pg8::EpiPlain, pg8::StaticOrder, false, true>(ring, g, So, E); }
}
#define XG(V) { static bool once_g##V = false; if (!once_g##V) { once_g##V = true; (void)hipFuncSetAttribute((const void*)probe_gemm<V>, hipFuncAttributeMaxDynamicSharedMemorySize, LDS_BYTES); } \
    hipLaunchKernelGGL((probe_gemm<V>), dim3(grid), dim3(NWAVES * 64), LDS_BYTES, stream, a); }
#endif
template <int PH_LO, int PH_HI>
__global__ void __launch_bounds__(NWAVES * 64, 2) yoco_fwd(Args args) {
    extern __shared__ __attribute__((aligned(16))) unsigned char lds[];
    Frame F;
    F.lds = (LAS unsigned char*)lds;
    F.MISC = (volatile LAS unsigned*)(F.lds + MISC_OFF);
    F.tid = threadIdx.x; F.lane = F.tid & 63; F.wave = __builtin_amdgcn_readfirstlane(F.tid >> 6);
    F.G = gridDim.x; { const int bx = blockIdx.x; F.vcu = (F.G % 8 == 0) ? (bx % 8) * (F.G / 8) + bx / 8 : bx; }
    unsigned char* ws = args.ws; F.ws = ws;
    F.ctl = (gu32*)(ws + WS_CTL);
    for (int u = F.tid; u < (LDS_BYTES - LDSCTL_OFF) / 4; u += NWAVES * 64) ((LAS unsigned*)(F.lds + LDSCTL_OFF))[u] = 0u;
    __syncthreads();
    XcdBarrier bar; bar.bar = (unsigned*)(F.ctl + CW_BAR); bar.x = 0; bar.st = nullptr;
    if (PH_HI - PH_LO > 1) bar = xcd_barrier_post((unsigned*)(F.ctl + CW_BAR), F.MISC + 8);
#ifdef PROBE_DOUBLE_BAR
#define GRID_BAR() do { if (PH_HI - PH_LO > 1) { xcd_barrier(bar); xcd_barrier(bar); } } while (0)
#else
#define GRID_BAR() do { if (PH_HI - PH_LO > 1) xcd_barrier(bar); } while (0)
#endif
    constexpr int lo = PH_LO, hi = PH_HI;
#define IN(k) (lo <= (k) && (k) < hi)
#define NEXTP(k) (((k) == 4 || (k) == 7 || (k) == 13) ? (k) + 2 : (k) + 1)
#define SEAM(k) do { if (IN(k) && IN(NEXTP(k))) GRID_BAR(); } while (0)
    LAS unsigned char* ring = F.lds + RING_OFF;
#define PHF(P) Frame P = F; { int t_ = F.tid; asm volatile("" : "+v"(t_)); t_ &= 511; P.tid = t_; P.lane = t_ & 63; }
    LAS float* xch = (LAS float*)(F.lds + X_OFF);
    LAS float* rtab = (LAS float*)(F.lds + LIST_OFF);
#define RT_RESET() do { if (F.tid == 0) rtab[0] = __int_as_float(-1); } while (0)

    if (EN_P0 && IN(0)) { PHF(P) p0_prologue(P); }
#ifdef PROBE_DOUBLE_P0
    GRID_BAR(); { PHF(P) p0_prologue(P); }
#endif
    SEAM(0);
    if (EN_P1 && IN(1)) {
        pg8::Gemm g{((bf16*)(F.ws + (WS_HN))), ((bf16*)(F.ws + (WS_WQKV))), S, NQKV, D}; pg8::RangeOrder So; So.init(S, NQKV, F.G, (int)blockIdx.x);
        pg8::EpiHeadNorm E{((bf16*)(F.ws + (WS_PROJ))), S, 0, 48, 4, 48, 16, INP(5), INP(6), QSCALE, nullptr, xch, ((float*)(F.ws + (WS_PSS))), rtab}; RT_RESET();
        const int ksplit = (10 * ((int)blockIdx.x & 7) + 3) / 7;
#pragma unroll 1
        for (int part = 0; part < 2; ++part) {
            So.i0 = part ? ksplit : 0; So.i1 = part ? (1 << 20) : ksplit;
            pg8::gemm_phase<pg8::EpiHeadNorm, pg8::RangeOrder, true, true>(ring, g, So, E);
            if (part == 0) { { PHF(P) convert_items(P, I_QKV, CVT_A_END, P.vcu * NWAVES + P.wave, P.G * NWAVES); } __syncthreads(); }
        }
#ifdef PROBE_DOUBLE_P1
        GRID_BAR(); RT_RESET(); So.i0 = 0; pg8::gemm_phase<pg8::EpiHeadNorm, pg8::RangeOrder, true, true>(ring, g, So, E);
#endif
        } SEAM(1);
#ifdef PROBE_INLINE_GEMM
    { GRID_BAR(); pg8::Gemm g{((bf16*)(F.ws + (WS_HN))), ((bf16*)(F.ws + (WS_WQKV))), S, PROBE_INLINE_GEMM, D}; pg8::StaticOrder So; So.init(S, PROBE_INLINE_GEMM, F.G, (int)blockIdx.x);
      pg8::EpiNull E{((bf16*)(F.ws + (WS_HID)))}; pg8::gemm_phase<pg8::EpiNull, pg8::StaticOrder, true, true>(ring, g, So, E); }
#endif
    if (EN_P2 && IN(2)) { PHF(P) p_dilated(P); }
#ifdef PROBE_DOUBLE_P2
    GRID_BAR(); { PHF(P) p_dilated(P); }
#endif
    SEAM(2);
    if (EN_P3 && IN(3)) { PHF(P) p_merge3(P); }
#ifdef PROBE_DOUBLE_P3
    GRID_BAR(); { PHF(P) p_merge3(P); }
#endif
    SEAM(3);
#ifdef PROBE_DOUBLE_GU
#define PROBE_REP_GU GRID_BAR(); RT_RESET(); pg8::gemm_phase<pg8::EpiSwiGLU, pg8::StaticOrder, true, true>(ring, g, So, E);
#else
#define PROBE_REP_GU
#endif
#define LAYER_TAIL(l) { const int pb = l ? 13 : 4; \
        if (EN_PWO && IN(pb)) { pg8::Gemm g{((bf16*)(F.ws + (WS_OB))), l ? ((bf16*)(F.ws + (WS_WOB))) : ((bf16*)(F.ws + (WS_WOA))), S, D, D}; pg8::StaticOrder So; So.init(S, D, F.G, (int)blockIdx.x); \
            pg8::EpiResNorm E{((bf16*)(F.ws + (WS_HN))), D, nullptr, ((float*)(F.ws + (WS_PSS))), xch}; \
            pg8::gemm_phase<pg8::EpiResNorm, pg8::StaticOrder, true, true, true>(ring, g, So, E); } SEAM(pb); \
        if (EN_PGU && IN(pb + 2)) { const int nhlp = 0;     \
            if ((int)blockIdx.x >= F.G - nhlp) { PHF(P) convert_items(P, CVT_B_END, CVT_C_END, ((int)blockIdx.x - (F.G - nhlp)) * NWAVES + P.wave, nhlp * NWAVES); } \
            else { pg8::Gemm g{((bf16*)(F.ws + (WS_HN))), ((bf16*)(F.ws + (WS_WGU))) + (size_t)l * NGU * D, S, NGU, D}; pg8::StaticOrder So; So.init(S, NGU, F.G - nhlp, (int)blockIdx.x); \
            pg8::EpiSwiGLU E{((bf16*)(F.ws + (WS_HID))), DFF, ((float*)(F.ws + (WS_PSS))), rtab}; RT_RESET(); \
            pg8::gemm_phase<pg8::EpiSwiGLU, pg8::StaticOrder, true, true>(ring, g, So, E); PROBE_REP_GU } \
            { PHF(P) convert_queue(P, l ? CVT_B_END : CVT_A_END, l ? CVT_C_END : CVT_B_END, F.ctl + (l ? CW_CVTC : CW_CVTB)); } } SEAM(pb + 2); \
        if (EN_PDN && IN(pb + 3)) { pg8::Gemm g{((bf16*)(F.ws + (WS_HID))), ((bf16*)(F.ws + (WS_WDN))) + (size_t)l * D * DFF, S, D, DFF}; pg8::StaticOrder So; So.init(S, D, F.G, (int)blockIdx.x); \
            pg8::EpiResNorm E{((bf16*)(F.ws + (WS_HN))), D, l ? OUTP() : (float*)nullptr, ((float*)(F.ws + (WS_PSS))), xch}; \
            pg8::gemm_phase<pg8::EpiResNorm, pg8::StaticOrder, true, true>(ring, g, So, E); } }
    LAYER_TAIL(0)
    SEAM(7);
    if (EN_P9 && IN(9)) { pg8::Gemm g{((bf16*)(F.ws + (WS_HN))), ((bf16*)(F.ws + (WS_WKV))), S, 3 * D, D}; pg8::StaticOrder So; So.init(S, 3 * D, F.G, (int)blockIdx.x);
        pg8::EpiHeadNorm E{((bf16*)(F.ws + (WS_PROJ))), S, 32, 16, 31, 0, 16, INP(12), INP(10), QSCALE, ((float*)(F.ws + (WS_KMEAN))), xch, ((float*)(F.ws + (WS_PSS))), rtab}; RT_RESET();
        pg8::gemm_phase<pg8::EpiHeadNorm, pg8::StaticOrder, true, true>(ring, g, So, E);
#ifdef PROBE_DOUBLE_P9
        GRID_BAR(); RT_RESET(); pg8::gemm_phase<pg8::EpiHeadNorm, pg8::StaticOrder, true, true>(ring, g, So, E);
#endif
        } SEAM(9);
    if (EN_P10 && IN(10)) { PHF(P) p_gate(P); }
#ifdef PROBE_DOUBLE_GATE
    GRID_BAR(); { PHF(P) p_gate(P); } GRID_BAR(); { PHF(P) p_gate(P); } GRID_BAR(); { PHF(P) p_gate(P); } GRID_BAR(); { PHF(P) p_gate(P); }
#endif
    SEAM(10);
#ifdef PROBE_P11_VARIANT
    if (EN_P11 && IN(11)) { { PHF(P) p_past<PROBE_P11_VARIANT>(P); } GRID_BAR(); }
#endif
    if (EN_P11 && IN(11)) { PHF(P) p_past<0>(P); } SEAM(11);
    if (EN_P12 && IN(12)) { PHF(P) p_own(P); }
#ifdef PROBE_DOUBLE_P12
    GRID_BAR(); { PHF(P) p_own(P); }
#endif
    SEAM(12);
    LAYER_TAIL(1)
#undef LAYER_TAIL
#undef PHF
#undef RT_RESET
#undef IN
#undef SEAM
#undef NEXTP
#undef GRID_BAR
}

extern "C" void kernel_launch(void* const* d_in, const int* in_sizes, int n_in, void* d_out, int out_size, void* d_ws, size_t ws_size, hipStream_t stream) {
    static int grid = 0;
    if (grid == 0) {
        if (n_in != 16 || in_sizes[0] != S * D || out_size != S * D || ws_size < WS_END) { fprintf(stderr, "kernel_launch: shape/workspace mismatch: n_in %d in0 %d out %d ws %zu (need %zu)\n", n_in, n_in > 0 ? in_sizes[0] : -1, out_size, ws_size, (size_t)WS_END); grid = -1; return; }
        int dev = 0, cus = 0, per_cu = 0;
        if (hipGetDevice(&dev) != hipSuccess || hipDeviceGetAttribute(&cus, hipDeviceAttributeMultiprocessorCount, dev) != hipSuccess) { fprintf(stderr, "kernel_launch: device query failed\n"); grid = -1; return; }
#if MK_PER_PHASE
        hipError_t fe = hipSuccess;
#define SETATTR(P) if (fe == hipSuccess) fe = hipFuncSetAttribute((const void*)yoco_fwd<P, P + 1>, hipFuncAttributeMaxDynamicSharedMemorySize, LDS_BYTES);
        SETATTR(0) SETATTR(1) SETATTR(2) SETATTR(3) SETATTR(4) SETATTR(5) SETATTR(6) SETATTR(7) SETATTR(8) SETATTR(9) SETATTR(10) SETATTR(11) SETATTR(12) SETATTR(13) SETATTR(14) SETATTR(15) SETATTR(16)
#undef SETATTR
        if (fe != hipSuccess) { fprintf(stderr, "kernel_launch: hipFuncSetAttribute failed\n"); grid = -1; return; }
#else
        if (hipFuncSetAttribute((const void*)yoco_fwd<0, N_PHASES>, hipFuncAttributeMaxDynamicSharedMemorySize, LDS_BYTES) != hipSuccess) { fprintf(stderr, "kernel_launch: hipFuncSetAttribute failed\n"); grid = -1; return; }
        if (hipOccupancyMaxActiveBlocksPerMultiprocessor(&per_cu, (const void*)yoco_fwd<0, N_PHASES>, NWAVES * 64, LDS_BYTES) != hipSuccess || per_cu < 1)
            fprintf(stderr, "kernel_launch: note: occupancy query reports %d workgroups per CU\n", per_cu);
#endif
        (void)hipGetLastError();
        grid = cus;
    }
    if (grid < 0) return;
    if (hipMemsetAsync((char*)d_ws + WS_CTL, 0, CTL_ZERO_BYTES, stream) != hipSuccess) { fprintf(stderr, "kernel_launch: memset failed\n"); return; }
    Args a{};
    for (int i = 0; i < 16; ++i) a.in[i] = (const float*)d_in[i];
    a.out = (float*)d_out; a.ws = (unsigned char*)d_ws;
#if MK_PER_PHASE
#define LAUNCH(P) hipLaunchKernelGGL((yoco_fwd<P, P + 1>), dim3(grid), dim3(NWAVES * 64), LDS_BYTES, stream, a);
    LAUNCH(0) LAUNCH(1) LAUNCH(2) LAUNCH(3) LAUNCH(4) LAUNCH(5) LAUNCH(6) LAUNCH(7) LAUNCH(8) LAUNCH(9) LAUNCH(10) LAUNCH(11) LAUNCH(12) LAUNCH(13) LAUNCH(14) LAUNCH(15) LAUNCH(16)
#undef LAUNCH
#else
    hipLaunchKernelGGL((yoco_fwd<0, N_PHASES>), dim3(grid), dim3(NWAVES * 64), LDS_BYTES, stream, a);
#endif
#ifdef PROBE_GEMM
    PROBE_GEMM
#endif
#ifdef PROBE_EXTRA
#define XL(P) { static bool once_##P = false; if (!once_##P) { once_##P = true; (void)hipFuncSetAttribute((const void*)yoco_fwd<P, P + 1>, hipFuncAttributeMaxDynamicSharedMemorySize, LDS_BYTES); } \
    hipLaunchKernelGGL((yoco_fwd<P, P + 1>), dim3(grid), dim3(NWAVES * 64), LDS_BYTES, stream, a); }
#ifdef PROBE_FLAG
    a.ph_lo = PROBE_FLAG;
#endif
    PROBE_EXTRA
#undef XL
#endif
    const hipError_t le = hipPeekAtLastError();
    if (le != hipSuccess) fprintf(stderr, "kernel_launch: launch failed: %s\n", hipGetErrorName(le));
}
```

```cpp
#include <hip/hip_runtime.h>
#include <cstdio>
#include <cstdint>
template <int M> __device__ __forceinline__ int xshf_i(int v) {
    if constexpr (M < 32) return __builtin_amdgcn_ds_swizzle(v, (M << 10) | 0x1f);
    else { const auto r = __builtin_amdgcn_permlane32_swap(v, v, false, false); return (int)((__builtin_amdgcn_mbcnt_hi(~0u, __builtin_amdgcn_mbcnt_lo(~0u, 0u)) < 32u) ? r[1] : r[0]); }
}
template <int M> __device__ __forceinline__ float xshf(float v) { return __builtin_bit_cast(float, xshf_i<M>(__builtin_bit_cast(int, v))); }
namespace pg8 {
#define PG8_LAS __attribute__((address_space(3)))
typedef unsigned short bf16_t;
typedef short bf16x8 __attribute__((ext_vector_type(8)));
typedef float f32x4 __attribute__((ext_vector_type(4)));
typedef unsigned u32x4 __attribute__((ext_vector_type(4)));
constexpr int BM = 256, BK = 64, HALF = 128, HTB = HALF * BK * 2  , STAGE_BYTES = 8 * HTB, NXCD = 8, WGM = 8;

__host__ __device__ __forceinline__ int lds_byte(int r, int c) { const int st = (r >> 4) * 2 + (c >> 5), rr = r & 15, cc = c & 31, ob = rr * 64 + cc * 2; return st * 1024 + (ob ^ (((ob >> 9) & 1) << 5)); }
__host__ __device__ __forceinline__ void stage_rc(int b, int& R, int& C) { const int st = b / 1024, sb = b % 1024, swz = sb ^ (((sb >> 9) & 1) << 5); R = (st >> 1) * 16 + swz / 64; C = (st & 1) * 32 + (swz % 64) / 2; }
__host__ __device__ __forceinline__ int perm32(int rho) { const int n = rho >> 4, i = rho & 15; return 8 * (i >> 2) + 4 * n + (i & 3); }

struct Unit { int pm, pn; };
struct Gemm { const bf16_t* A; const bf16_t* Bt; int M, N, K; };

struct StaticOrder {
    int nM, nN, nwg, G, c;
    __host__ __device__ void init(int M, int N, int G_, int c_) { nM = M / BM; nN = N / BM; nwg = nM * nN; G = G_; c = c_; }
    __host__ __device__ bool next(int i, Unit& u) const {
        const long L = (long)i * G + c; if (L >= nwg) return false;
        int wgid = (int)L; { const int q = nwg / NXCD, r = nwg % NXCD, xcd = wgid % NXCD, off = wgid / NXCD; wgid = (xcd < r ? xcd * (q + 1) : r * (q + 1) + (xcd - r) * q) + off; }
        const int nig = WGM * nN, gid = wgid / nig, fm = gid * WGM, gsz = (nM - fm) < WGM ? (nM - fm) : WGM;
        u.pm = fm + ((wgid % nig) % gsz); u.pn = (wgid % nig) / gsz; return true;
    }
    __device__ __forceinline__ void a_ready(const Unit&) const {}
    __device__ __forceinline__ void done(const Unit&) const {}
};

struct RangeOrder : StaticOrder {
    int i0, i1;
    __host__ __device__ bool next(int i, Unit& u) const { return (i0 + i < i1) && StaticOrder::next(i0 + i, u); }
};

__device__ __forceinline__ unsigned cvt_pk_bf16(float lo, float hi) { unsigned r; asm volatile("v_cvt_pk_bf16_f32 %0, %1, %2" : "=v"(r) : "v"(lo), "v"(hi)); return r; }
typedef float f32x2 __attribute__((ext_vector_type(2)));

constexpr float RMS_EPS = 1e-6f;

#ifndef STORE_POLICY
#define STORE_POLICY 0
#endif
__device__ __forceinline__ void st16(void* p, u32x4 v) {
#if STORE_POLICY == 1
    asm volatile("global_store_dwordx4 %0, %1, off sc1" :: "v"(p), "v"(v) : "memory");
#elif STORE_POLICY == 2
    __builtin_nontemporal_store(v, (u32x4*)p);
#else
    *(u32x4*)p = v;
#endif
}
__device__ __forceinline__ void st16f(void* p, f32x4 v) { st16(p, __builtin_bit_cast(u32x4, v)); }

__device__ __forceinline__ void rstd_panel(PG8_LAS float* rt, const float* pss, int pm, int tid) {
    if (__builtin_amdgcn_readfirstlane(__float_as_int(rt[0])) != pm) {
        asm volatile("s_waitcnt lgkmcnt(0)" ::: "memory"); __builtin_amdgcn_s_barrier(); asm volatile("" ::: "memory");
        if (tid < BM) { const f32x4* p = (const f32x4*)(pss + (size_t)(pm * BM + tid) * 16);
            const f32x4 a = p[0], b = p[1], c = p[2], d = p[3];
            const float s = (((a[0] + a[1]) + (a[2] + a[3])) + ((b[0] + b[1]) + (b[2] + b[3]))) + (((c[0] + c[1]) + (c[2] + c[3])) + ((d[0] + d[1]) + (d[2] + d[3])));
            rt[1 + tid] = __builtin_amdgcn_rsqf(s * (1.0f / 4096.0f) + RMS_EPS); }
        if (tid == 0) rt[0] = __int_as_float(pm);
        asm volatile("s_waitcnt lgkmcnt(0)" ::: "memory"); __builtin_amdgcn_s_barrier(); asm volatile("" ::: "memory");
    }
}
struct EpiHeadNorm {
    static constexpr bool PERM = true, AFTER_DRAIN = false, INIT_BASE = false;
    bf16_t* O; int ldc; int q0, n_q, q_shift, k0, n_k; const float* gq; const float* gk; float qscale; float* kmean; PG8_LAS float* X; const float* pss; PG8_LAS float* rt;
    __device__ __forceinline__ void operator()(const f32x4 (&acc0)[2][2][4][2], const Unit& u, int wr, int wc, int fr, int fq) const {
        const int pn = u.pn, row0 = u.pm * BM + wr * 64 + fr;
        const bool isq = (pn >= q0) && (pn < q0 + n_q), isk = (pn >= k0) && (pn < k0 + n_k);
        bf16_t* Ob = O + (size_t)(2 * pn) * ldc * 128 + wc * 32 + 8 * fq; const size_t hstr = (size_t)ldc * 128;
        rstd_panel(rt, pss, u.pm, (wr * 4 + wc) * 64 + fq * 16 + fr);
        f32x4 acc[2][2][4][2];
#pragma unroll
        for (int ai = 0; ai < 2; ++ai)
#pragma unroll
            for (int m = 0; m < 4; ++m) { const float rr = rt[1 + ai * HALF + wr * 64 + m * 16 + fr];
#pragma unroll
                for (int bj = 0; bj < 2; ++bj) { acc[ai][bj][m][0] = acc0[ai][bj][m][0] * rr; acc[ai][bj][m][1] = acc0[ai][bj][m][1] * rr; } }
        if (!isq && !isk) {
#pragma unroll
            for (int ai = 0; ai < 2; ++ai)
#pragma unroll
                for (int m = 0; m < 4; ++m) { bf16_t* rowp = Ob + (size_t)(row0 + ai * HALF + m * 16) * 128;
#pragma unroll
                    for (int bj = 0; bj < 2; ++bj) { const f32x4 v0 = acc[ai][bj][m][0], v1 = acc[ai][bj][m][1];
                        u32x4 w; w.x = cvt_pk_bf16(v0[0], v0[1]); w.y = cvt_pk_bf16(v0[2], v0[3]); w.z = cvt_pk_bf16(v1[0], v1[1]); w.w = cvt_pk_bf16(v1[2], v1[3]);
                        st16(rowp + bj * hstr, w); } }
            return;
        }
        const float* g = isq ? gq + ((pn - q0) >> q_shift) * 128 : gk;
        const float sc = isq ? qscale : 1.f;
#pragma unroll
        for (int ai = 0; ai < 2; ++ai)
#pragma unroll
            for (int bj = 0; bj < 2; ++bj)
#pragma unroll
                for (int m = 0; m < 4; ++m) { const f32x4 a = acc[ai][bj][m][0], b = acc[ai][bj][m][1];
                    float s = ((a[0] * a[0] + a[1] * a[1]) + (a[2] * a[2] + a[3] * a[3])) + ((b[0] * b[0] + b[1] * b[1]) + (b[2] * b[2] + b[3] * b[3]));
                    s += xshf<16>(s); s += xshf<32>(s);
                    if (fq == 0) X[((ai * HALF + wr * 64 + m * 16 + fr) * 2 + bj) * 4 + wc] = s; }
        asm volatile("s_waitcnt lgkmcnt(0)" ::: "memory"); __builtin_amdgcn_s_barrier(); asm volatile("" ::: "memory");
        const f32x4 g0 = *(const f32x4*)(g + wc * 32 + 8 * fq), g1 = *(const f32x4*)(g + wc * 32 + 8 * fq + 4);
        f32x4 cs[2][2];
#pragma unroll
        for (int bj = 0; bj < 2; ++bj) { cs[bj][0] = (f32x4){0.f, 0.f, 0.f, 0.f}; cs[bj][1] = (f32x4){0.f, 0.f, 0.f, 0.f}; }
#pragma unroll
        for (int ai = 0; ai < 2; ++ai)
#pragma unroll
            for (int m = 0; m < 4; ++m) { bf16_t* rowp = Ob + (size_t)(row0 + ai * HALF + m * 16) * 128;
#pragma unroll
                for (int bj = 0; bj < 2; ++bj) { const f32x4 p = *(const PG8_LAS f32x4*)(X + ((ai * HALF + wr * 64 + m * 16 + fr) * 2 + bj) * 4);
                    const float rs = __builtin_amdgcn_rsqf(((p[0] + p[1]) + (p[2] + p[3])) * (1.0f / 128.0f) + RMS_EPS) * sc;
                    const f32x4 v0 = acc[ai][bj][m][0] * rs * g0, v1 = acc[ai][bj][m][1] * rs * g1;
                    cs[bj][0] += v0; cs[bj][1] += v1;
                    u32x4 w; w.x = cvt_pk_bf16(v0[0], v0[1]); w.y = cvt_pk_bf16(v0[2], v0[3]); w.z = cvt_pk_bf16(v1[0], v1[1]); w.w = cvt_pk_bf16(v1[2], v1[3]);
                    st16(rowp + bj * hstr, w); } }
        if (kmean != nullptr && !isq) {
#pragma unroll
            for (int bj = 0; bj < 2; ++bj)
#pragma unroll
                for (int n = 0; n < 2; ++n)
#pragma unroll
                    for (int j = 0; j < 4; ++j) { float s = cs[bj][n][j];
                        s += xshf<1>(s); s += xshf<2>(s); s += xshf<4>(s); s += xshf<8>(s);
                        if (fr == 0) atomicAdd(kmean + (size_t)u.pm * 4096 + (pn - k0) * BM + bj * HALF + wc * 32 + 8 * fq + 4 * n + j, s * (1.0f / 256.0f)); }
        }
    }
};
struct EpiResNorm {
    static constexpr bool PERM = true, AFTER_DRAIN = false, INIT_BASE = true;
    bf16_t* XB; int ldc; float* outf; float* PSS; PG8_LAS float* X;
    __device__ __forceinline__ void init(f32x4 (&acc)[2][2][4][2], const Unit& u, int wr, int wc, int fr, int fq) const {
        const int row0 = u.pm * BM + wr * 64 + fr, col0 = u.pn * BM + wc * 32 + 8 * fq;
        u32x4 raw[2][4][2];
#pragma unroll
        for (int ai = 0; ai < 2; ++ai)
#pragma unroll
            for (int m = 0; m < 4; ++m)
#pragma unroll
                for (int bj = 0; bj < 2; ++bj) raw[ai][m][bj] = *(const u32x4*)(XB + (size_t)(row0 + ai * HALF + m * 16) * ldc + col0 + bj * HALF);
#pragma unroll
        for (int ai = 0; ai < 2; ++ai)
#pragma unroll
            for (int m = 0; m < 4; ++m)
#pragma unroll
                for (int bj = 0; bj < 2; ++bj) { const u32x4 r = raw[ai][m][bj];
                    acc[ai][bj][m][0] = (f32x4){__uint_as_float(r.x << 16), __uint_as_float(r.x & 0xffff0000u), __uint_as_float(r.y << 16), __uint_as_float(r.y & 0xffff0000u)};
                    acc[ai][bj][m][1] = (f32x4){__uint_as_float(r.z << 16), __uint_as_float(r.z & 0xffff0000u), __uint_as_float(r.w << 16), __uint_as_float(r.w & 0xffff0000u)}; }
    }
    __device__ __forceinline__ void operator()(const f32x4 (&acc)[2][2][4][2], const Unit& u, int wr, int wc, int fr, int fq) const {
        const int row0 = u.pm * BM + wr * 64 + fr, col0 = u.pn * BM + wc * 32 + 8 * fq;
#pragma unroll
        for (int ai = 0; ai < 2; ++ai)
#pragma unroll
            for (int m = 0; m < 4; ++m) { const size_t off = (size_t)(row0 + ai * HALF + m * 16) * ldc + col0;
                float ss = 0.f;
#pragma unroll
                for (int bj = 0; bj < 2; ++bj) { const f32x4 v0 = acc[ai][bj][m][0], v1 = acc[ai][bj][m][1];
                    if (outf != nullptr) { st16f(outf + off + bj * HALF, v0); st16f(outf + off + bj * HALF + 4, v1); }
                    else { ss += ((v0[0] * v0[0] + v0[1] * v0[1]) + (v0[2] * v0[2] + v0[3] * v0[3])) + ((v1[0] * v1[0] + v1[1] * v1[1]) + (v1[2] * v1[2] + v1[3] * v1[3]));
                        u32x4 w; w.x = cvt_pk_bf16(v0[0], v0[1]); w.y = cvt_pk_bf16(v0[2], v0[3]); w.z = cvt_pk_bf16(v1[0], v1[1]); w.w = cvt_pk_bf16(v1[2], v1[3]);
                        st16(XB + off + bj * HALF, w); } }
                if (outf == nullptr) { ss += xshf<16>(ss); ss += xshf<32>(ss); if (fq == 0) X[(ai * HALF + wr * 64 + m * 16 + fr) * 4 + wc] = ss; } }
        if (outf == nullptr) {
            asm volatile("s_waitcnt lgkmcnt(0)" ::: "memory"); __builtin_amdgcn_s_barrier(); asm volatile("" ::: "memory");
            const int t = (wr * 4 + wc) * 64 + fq * 16 + fr;
            if (t < BM) { const f32x4 p = *(const PG8_LAS f32x4*)(X + t * 4); PSS[(size_t)(u.pm * BM + t) * 16 + u.pn] = (p[0] + p[1]) + (p[2] + p[3]); }
        }
    }
};
struct EpiSwiGLU {
    static constexpr bool PERM = true, AFTER_DRAIN = false, INIT_BASE = false;
    bf16_t* H; int ldh; const float* pss; PG8_LAS float* rt;
    static __device__ __forceinline__ f32x4 sw4(const f32x4 g, const f32x4 up, const f32x2 rs) {
        const f32x4 t = g * rs[0];
        f32x4 d = {__builtin_amdgcn_exp2f(t[0]), __builtin_amdgcn_exp2f(t[1]), __builtin_amdgcn_exp2f(t[2]), __builtin_amdgcn_exp2f(t[3])};
        d = d + 1.0f;
        f32x4 r = {__builtin_amdgcn_rcpf(d[0]), __builtin_amdgcn_rcpf(d[1]), __builtin_amdgcn_rcpf(d[2]), __builtin_amdgcn_rcpf(d[3])};
        r = r * rs[1];
        return (g * up) * r;
    }
    __device__ __forceinline__ void operator()(const f32x4 (&acc)[2][2][4][2], const Unit& u, int wr, int wc, int fr, int fq) const {
        const int row0 = u.pm * BM + wr * 64 + fr, col0 = u.pn * HALF + wc * 32 + 8 * fq;
        rstd_panel(rt, pss, u.pm, (wr * 4 + wc) * 64 + fq * 16 + fr);
#pragma unroll
        for (int ai = 0; ai < 2; ++ai)
#pragma unroll
            for (int m = 0; m < 4; ++m) { const float rr = rt[1 + ai * HALF + wr * 64 + m * 16 + fr];
                const f32x2 rs = {rr * -1.4426950408889634f, rr * rr};
                const f32x4 ha = sw4(acc[ai][0][m][0], acc[ai][1][m][0], rs), hb = sw4(acc[ai][0][m][1], acc[ai][1][m][1], rs);
                u32x4 w; w.x = cvt_pk_bf16(ha[0], ha[1]); w.y = cvt_pk_bf16(ha[2], ha[3]); w.z = cvt_pk_bf16(hb[0], hb[1]); w.w = cvt_pk_bf16(hb[2], hb[3]);
                st16(H + (size_t)(row0 + ai * HALF + m * 16) * ldh + col0, w); }
    }
};

template <class Epi, class Sched, bool ALIGN_EPI = false, bool SP2 = false, bool A_HM = false, bool B_BLK = true>
__device__ __forceinline__ void gemm_phase(PG8_LAS unsigned char* lds, const Gemm g, const Sched& S, const Epi& E) {
    int tid_ = threadIdx.x; asm volatile("" : "+v"(tid_)); tid_ &= 511;
    const int tid = tid_, wid = __builtin_amdgcn_readfirstlane(tid >> 6), lane = tid & 63, wr = wid >> 2, wc = wid & 3, fr = lane & 15, fq = lane >> 4;
    const int K = g.K, nt = K / BK;
    unsigned voffA[2], voffB[2];
#pragma unroll
    for (int i = 0; i < 2; ++i) { int R, C; stage_rc(tid * 16 + i * 8192, R, C); const int Rb = Epi::PERM ? ((R & ~31) + perm32(R & 31)) : R;
        voffA[i] = (unsigned)(R * (A_HM ? 128 : K) + C) * 2u; voffB[i] = (unsigned)(Rb * (B_BLK ? 64 : K) + C) * 2u; }
    const size_t kstep = (size_t)(BK * 2);
    const size_t hstep = (size_t)HALF * K * 2;
    const size_t tstep = 2 * hstep;
    const size_t hstepA = A_HM ? (size_t)HALF * 256 : hstep, tstepA = 2 * hstepA, headA = (size_t)g.M * 256;
    const size_t kstepB = B_BLK ? (size_t)32768 : kstep, hstepB = B_BLK ? (size_t)16384 : hstep;
#define PG8_AK(t) (A_HM ? (size_t)((t) >> 1) * headA + (size_t)((t) & 1) * 128 : (size_t)(t) * kstep)
    const unsigned ldsw = (unsigned)wid * 1024u;
    const int aoff = lds_byte(wr * 64 + fr, fq * 8), boff = lds_byte(wc * 32 + fr, fq * 8);
#define PG8_SA(b, h) (((b) * 2 + (h)) * HTB)
#define PG8_SB(b, h) ((4 + (b) * 2 + (h)) * HTB)
#define PG8_STAGE(bufoff, gbase, voff) do { _Pragma("unroll") for (int _i = 0; _i < 2; ++_i) \
        __builtin_amdgcn_global_load_lds((const unsigned*)((const char*)(gbase) + (voff)[_i]), (PG8_LAS unsigned*)(lds + (bufoff) + ldsw + _i * 8192), 16, 0, 0); } while (0)
#define PG8_LDA(dst, b, h) do { _Pragma("unroll") for (int m = 0; m < 4; ++m) _Pragma("unroll") for (int k = 0; k < 2; ++k) dst[m][k] = *(const PG8_LAS bf16x8*)(lds + PG8_SA(b, h) + aoff + m * 2048 + k * 1024); } while (0)
#define PG8_LDB(dst, b, h) do { _Pragma("unroll") for (int n = 0; n < 2; ++n) _Pragma("unroll") for (int k = 0; k < 2; ++k) dst[n][k] = *(const PG8_LAS bf16x8*)(lds + PG8_SB(b, h) + boff + n * 2048 + k * 1024); } while (0)
#define PG8_MMA(ai, bj, At, Bt) do { __builtin_amdgcn_s_setprio(1); _Pragma("unroll") for (int m = 0; m < 4; ++m) _Pragma("unroll") for (int n = 0; n < 2; ++n) _Pragma("unroll") for (int k = 0; k < 2; ++k) \
        acc[ai][bj][m][n] = __builtin_amdgcn_mfma_f32_16x16x32_bf16(Bt[n][k], At[m][k], acc[ai][bj][m][n], 0, 0, 0); __builtin_amdgcn_s_setprio(0); } while (0)
#define PG8_WAIT_V(n) asm volatile("s_waitcnt vmcnt(" #n ")" ::: "memory")
#define PG8_WAIT_L(n) asm volatile("s_waitcnt lgkmcnt(" #n ")" ::: "memory")
#define PG8_BAR __builtin_amdgcn_s_barrier()
#define PG8_SCHED __builtin_amdgcn_sched_barrier(0)
#define PG8_ACC_INIT(U) do { if constexpr (Epi::INIT_BASE) { E.init(acc, (U), wr, wc, fr, fq); \
        _Pragma("unroll") for (int a = 0; a < 2; ++a) _Pragma("unroll") for (int b = 0; b < 2; ++b) _Pragma("unroll") for (int m = 0; m < 4; ++m) _Pragma("unroll") for (int n = 0; n < 2; ++n) asm volatile("" : "+v"(acc[a][b][m][n])); } \
    else { _Pragma("unroll") for (int a = 0; a < 2; ++a) _Pragma("unroll") for (int b = 0; b < 2; ++b) _Pragma("unroll") for (int m = 0; m < 4; ++m) _Pragma("unroll") for (int n = 0; n < 2; ++n) acc[a][b][m][n] = (f32x4){0.f, 0.f, 0.f, 0.f}; } } while (0)
    Unit cur, nxt; int ui = 0;
    if (!S.next(0, cur)) return;
    f32x4 acc[2][2][4][2];
    PG8_ACC_INIT(cur);
    bf16x8 At[4][2], B0[2][2], B1[2][2];
    const char* cA = (const char*)g.A + (size_t)cur.pm * tstepA; const char* cB = (const char*)g.Bt + (size_t)cur.pn * tstep;
    S.a_ready(cur);
    if constexpr (SP2) {
        PG8_STAGE(PG8_SB(0, 0), cB, voffB); PG8_STAGE(PG8_SB(0, 1), cB + hstepB, voffB); PG8_STAGE(PG8_SA(0, 0), cA, voffA); PG8_STAGE(PG8_SA(0, 1), cA + hstepA, voffA);
        if (wr == 1) PG8_BAR;
        PG8_WAIT_V(2); PG8_BAR;
        PG8_STAGE(PG8_SB(1, 0), cB + kstepB, voffB); PG8_STAGE(PG8_SA(1, 0), cA + kstep, voffA); PG8_STAGE(PG8_SB(1, 1), cB + hstepB + kstepB, voffB);
        PG8_WAIT_V(6); PG8_BAR;
    } else {
        PG8_STAGE(PG8_SB(0, 0), cB, voffB); PG8_STAGE(PG8_SA(0, 0), cA, voffA); PG8_STAGE(PG8_SB(0, 1), cB + hstepB, voffB); PG8_STAGE(PG8_SA(0, 1), cA + hstepA, voffA);
        if (wr == 1) PG8_BAR;
        PG8_WAIT_V(4); PG8_BAR;
        PG8_STAGE(PG8_SB(1, 0), cB + kstepB, voffB); PG8_STAGE(PG8_SA(1, 0), cA + kstep, voffA); PG8_STAGE(PG8_SB(1, 1), cB + hstepB + kstepB, voffB);
        PG8_WAIT_V(6); PG8_BAR;
    }
    for (;;) {
        const bool has_next = S.next(ui + 1, nxt);
        const char* nA = has_next ? (const char*)g.A + (size_t)nxt.pm * tstepA : cA; const char* nB = has_next ? (const char*)g.Bt + (size_t)nxt.pn * tstep : cB;
        for (int t = 0; t < nt; t += 2) {
            const bool last = (t == nt - 2);
            const char* a1 = cA + PG8_AK(t + 1);
            const char* a2 = last ? nA : cA + PG8_AK(t + 2); const char* b2 = last ? nB : cB + (size_t)(t + 2) * kstepB;
            const char* a3 = a2 + kstep; const char* b3 = b2 + kstepB;
            if (last && has_next) S.a_ready(nxt);
            if constexpr (SP2) {
            PG8_LDB(B0, 0, 0); PG8_LDB(B1, 0, 1); PG8_SCHED; PG8_LDA(At, 0, 0); PG8_STAGE(PG8_SA(1, 1), a1 + hstepA, voffA);
            PG8_WAIT_V(8); PG8_WAIT_L(0); PG8_BAR; PG8_MMA(0, 0, At, B0); PG8_MMA(0, 1, At, B1); PG8_BAR; PG8_SCHED;
            PG8_LDA(At, 0, 1); PG8_STAGE(PG8_SB(0, 0), b2, voffB); PG8_STAGE(PG8_SB(0, 1), b2 + hstepB, voffB); PG8_STAGE(PG8_SA(0, 0), a2, voffA);
            PG8_WAIT_V(8); PG8_WAIT_L(0); PG8_BAR; PG8_MMA(1, 0, At, B0); PG8_MMA(1, 1, At, B1); PG8_BAR; PG8_SCHED;
            PG8_LDB(B0, 1, 0); PG8_LDB(B1, 1, 1); PG8_SCHED; PG8_LDA(At, 1, 0); PG8_STAGE(PG8_SA(0, 1), a2 + hstepA, voffA);
            PG8_WAIT_V(8); PG8_WAIT_L(0); PG8_BAR; PG8_MMA(0, 0, At, B0); PG8_MMA(0, 1, At, B1); PG8_BAR; PG8_SCHED;
            PG8_LDA(At, 1, 1); PG8_STAGE(PG8_SB(1, 0), b3, voffB); PG8_STAGE(PG8_SB(1, 1), b3 + hstepB, voffB); PG8_STAGE(PG8_SA(1, 0), a3, voffA);
            PG8_WAIT_V(8); PG8_WAIT_L(0); PG8_BAR; PG8_MMA(1, 0, At, B0); PG8_MMA(1, 1, At, B1); PG8_BAR; PG8_SCHED;
            } else {
            PG8_LDB(B0, 0, 0); PG8_SCHED; PG8_LDA(At, 0, 0); PG8_STAGE(PG8_SA(1, 1), a1 + hstepA, voffA);
            PG8_WAIT_L(8); PG8_BAR; PG8_WAIT_L(0); PG8_MMA(0, 0, At, B0); PG8_BAR; PG8_SCHED;
            PG8_LDB(B1, 0, 1); PG8_STAGE(PG8_SB(0, 0), b2, voffB);
            PG8_BAR; PG8_WAIT_L(0); PG8_MMA(0, 1, At, B1); PG8_BAR;
            PG8_LDA(At, 0, 1); PG8_STAGE(PG8_SA(0, 0), a2, voffA);
            PG8_BAR; PG8_WAIT_L(0); PG8_MMA(1, 0, At, B0); PG8_BAR; PG8_SCHED;
            PG8_STAGE(PG8_SB(0, 1), b2 + hstepB, voffB);
            PG8_WAIT_V(6); PG8_BAR; PG8_MMA(1, 1, At, B1); PG8_BAR;
            PG8_LDB(B0, 1, 0); PG8_SCHED; PG8_LDA(At, 1, 0); PG8_STAGE(PG8_SA(0, 1), a2 + hstepA, voffA);
            PG8_WAIT_L(8); PG8_BAR; PG8_WAIT_L(0); PG8_MMA(0, 0, At, B0); PG8_BAR; PG8_SCHED;
            PG8_LDB(B1, 1, 1); PG8_STAGE(PG8_SB(1, 0), b3, voffB);
            PG8_BAR; PG8_WAIT_L(0); PG8_MMA(0, 1, At, B1); PG8_BAR;
            PG8_LDA(At, 1, 1); PG8_STAGE(PG8_SA(1, 0), a3, voffA);
            PG8_BAR; PG8_WAIT_L(0); PG8_MMA(1, 0, At, B0); PG8_BAR; PG8_SCHED;
            PG8_STAGE(PG8_SB(1, 1), b3 + hstepB, voffB);
            PG8_WAIT_V(6); PG8_BAR; PG8_MMA(1, 1, At, B1); PG8_BAR;
            }
        }
        if constexpr (ALIGN_EPI) { if (wr == 0) PG8_BAR; }
        if constexpr (!Epi::AFTER_DRAIN) { E(acc, cur, wr, wc, fr, fq); S.done(cur); }
        if (!has_next) break;
        PG8_ACC_INIT(nxt);
        cur = nxt; cA = nA; cB = nB; ++ui;
        if constexpr (ALIGN_EPI) { if (wr == 1) PG8_BAR; }
    }
    PG8_WAIT_V(0);
    if constexpr (!ALIGN_EPI) { if (wr == 0) PG8_BAR; }
    PG8_BAR;
    if constexpr (Epi::AFTER_DRAIN) { E.fused(acc, cur, wr, wc, fr, fq, lds, wid, lane); S.done(cur); }
#undef PG8_SA
#undef PG8_SB
#undef PG8_STAGE
#undef PG8_LDA
#undef PG8_LDB
#undef PG8_MMA
#undef PG8_WAIT_V
#undef PG8_WAIT_L
#undef PG8_BAR
#undef PG8_SCHED
#undef PG8_AK
#undef PG8_ACC_INIT
}
}

constexpr int NWAVES = 8;
constexpr int S = 8192, D = 4096, NH = 32, HD = 128, DFF = 11008, NQKV = 5 * D, NGU = 2 * DFF;
constexpr float LOG2E = 1.4426950408889634f;
constexpr float QSCALE = 0.08838834764831845f * LOG2E;
constexpr float M2_QK = 11.313708498984761f * LOG2E;
#ifndef MK_PER_PHASE
#define MK_PER_PHASE 0
#endif
constexpr int N_PHASES = 17;

constexpr size_t MiB = 1u << 20;
constexpr size_t WS_CTL = 0, CTL_ZERO_BYTES = 640 * 1024;
constexpr size_t WS_KMEAN = 64 * 1024;
constexpr size_t WS_PSS = 2 * MiB;
constexpr size_t WS_WQKV = 4 * MiB;
constexpr size_t WS_WOA  = WS_WQKV + 160 * MiB;
constexpr size_t WS_WGU  = WS_WOA + 32 * MiB;
constexpr size_t WS_WDN  = WS_WGU + 344 * MiB;
constexpr size_t WS_WKV  = WS_WDN + 172 * MiB;
constexpr size_t WS_WQB  = WS_WKV + 64 * MiB;
constexpr size_t WS_WOB  = WS_WQB + 32 * MiB;
constexpr size_t WS_HN   = WS_WOB + 32 * MiB;
constexpr size_t WS_HN2  = WS_HN + 64 * MiB;
constexpr size_t WS_PROJ = WS_HN2 + 64 * MiB;
constexpr size_t WS_PART = WS_PROJ + 320 * MiB;
constexpr size_t WS_LPART = WS_PART + 192 * MiB;
constexpr size_t WS_OB   = WS_LPART + 4 * MiB;
constexpr size_t WS_X1   = WS_OB + 64 * MiB;
constexpr size_t WS_X2   = WS_X1 + 128 * MiB;
constexpr size_t WS_HID  = WS_X2 + 128 * MiB;
constexpr size_t WS_SEL  = WS_HID + 172 * MiB;
constexpr size_t WS_END  = WS_SEL + 1 * MiB;
constexpr int CW_TMO = 0, CW_CODE = 1, CW_BAR = 4096, CW_QUEUE = 8192, CW_CVTB = 8256, CW_CVTC = 8320, CW_CVTA = 8384;

constexpr int RING_OFF = 0, RING_BYTES = 131072;
constexpr int X_OFF = RING_BYTES, X_BYTES = 8192;
constexpr int LIST_OFF = X_OFF + X_BYTES, LIST_BYTES = 12288;
constexpr int LDSCTL_OFF = LIST_OFF + LIST_BYTES, MISC_OFF = LDSCTL_OFF + 320;
constexpr int BIAS_OFF = LDSCTL_OFF + 512, BIAS_BYTES = 4096;
constexpr int LDS_BYTES = BIAS_OFF + BIAS_BYTES;
#define GAS __attribute__((address_space(1)))
#define LAS __attribute__((address_space(3)))
typedef unsigned short bf16;
typedef unsigned v4u __attribute__((ext_vector_type(4)));
typedef float f32x4 __attribute__((ext_vector_type(4)));
typedef short bf16x8 __attribute__((ext_vector_type(8)));
typedef GAS unsigned gu32;
typedef GAS unsigned long long gu64;
#define RLX_AGENT __ATOMIC_RELAXED, __HIP_MEMORY_SCOPE_AGENT
#define LDS_WAIT() asm volatile("s_waitcnt lgkmcnt(0)" ::: "memory")
#define VM_WAIT() asm volatile("s_waitcnt vmcnt(0)" ::: "memory")
__device__ __forceinline__ unsigned long long rt() { return __builtin_amdgcn_s_memrealtime(); }
__device__ __forceinline__ unsigned f2bf(float f) { unsigned u = __builtin_bit_cast(unsigned, f); return (u + 0x7fffu + ((u >> 16) & 1u)) >> 16; }
__device__ __forceinline__ unsigned pk2(float lo, float hi) { return f2bf(lo) | (f2bf(hi) << 16); }

#define XB_TMO      128
#define XB_XCNT(j)  (256  + 64 * (j))
#define XB_XSUB(j)  (1280 + 64 * (j))
#define XB_XGEN(j)  (2304 + 64 * (j))
#define XB_TOP      3328
#define XB_TOPGEN   3392
#define XCD_BAR_WORDS 3456
#define XB_SPIN_CAP (1u << 18)

__device__ __forceinline__ unsigned xb_ld(unsigned* p)              { return __hip_atomic_load(p, __ATOMIC_RELAXED, __HIP_MEMORY_SCOPE_AGENT); }
__device__ __forceinline__ unsigned xb_add(unsigned* p, unsigned v) { return __hip_atomic_fetch_add(p, v, __ATOMIC_RELAXED, __HIP_MEMORY_SCOPE_AGENT); }
__device__ __forceinline__ unsigned xb_xcc_id() { return (unsigned)__builtin_amdgcn_s_getreg((3 << 11) | 20) & 0xFu; }
#define XB_SPIN(cond, bar) do { unsigned _sp = 0; while (cond) { __builtin_amdgcn_s_sleep(1); \
    if ((++_sp & 255u) == 0u) { if (xb_ld(&(bar)[XB_TMO])) break; if (_sp > XB_SPIN_CAP) { atomicAdd(&(bar)[XB_TMO], 1u); break; } } } } while (0)

struct XcdBarrier {
    unsigned* bar; unsigned x;
    volatile LAS unsigned* st;
};

__device__ __forceinline__ XcdBarrier xcd_barrier_post(unsigned* bar, volatile LAS unsigned* st) {
    XcdBarrier b; b.bar = bar; b.x = xb_xcc_id(); b.st = st;
    if (threadIdx.x == 0) (void)xb_add(&bar[XB_XCNT(b.x)], 1u);
    return b;
}
__device__ __forceinline__ void xcd_barrier_complete(unsigned* bar, unsigned x, unsigned& nloc, unsigned& nx) {
    const unsigned G = gridDim.x * gridDim.y * gridDim.z;
    unsigned sum, cnt, mine, sp = 0u;
    for (;;) {
        sum = 0u; cnt = 0u; mine = 0u;
#pragma unroll
        for (unsigned j = 0; j < 16; ++j) { const unsigned c = xb_ld(&bar[XB_XCNT(j)]); sum += c; cnt += (c > 0u) ? 1u : 0u; mine = (j == x) ? c : mine; }
        if (sum == G) break;
        __builtin_amdgcn_s_sleep(1);
        if ((++sp & 255u) == 0u) { if (xb_ld(&bar[XB_TMO])) break; if (sp > XB_SPIN_CAP) { atomicAdd(&bar[XB_TMO], 1u); break; } }
    }
    nloc = mine > 0u ? mine : 1u; nx = cnt > 0u ? cnt : 1u;
}

__device__ __forceinline__ void xcd_barrier(const XcdBarrier& b) {
    asm volatile("s_waitcnt vmcnt(0)" ::: "memory");
    __syncthreads();
    if (threadIdx.x == 0) {
        unsigned* bar = b.bar;
        __builtin_amdgcn_s_waitcnt(0);
        unsigned nloc = b.st[0], nx = b.st[1];
        if (nloc == 0u) { xcd_barrier_complete(bar, b.x, nloc, nx); b.st[0] = nloc; b.st[1] = nx; }
        const unsigned old = xb_add(&bar[XB_XSUB(b.x)], 1u);
        const unsigned gen = old / nloc;
        if (old + 1u == (gen + 1u) * nloc) {
            __builtin_amdgcn_fence(__ATOMIC_RELEASE, "agent");
            asm volatile("s_waitcnt vmcnt(0)" ::: "memory");
            const unsigned og = xb_add(&bar[XB_TOP], 1u);
            const unsigned tg = og / nx;
            if (og + 1u == (tg + 1u) * nx) xb_add(&bar[XB_TOPGEN], 1u);
            else XB_SPIN(xb_ld(&bar[XB_TOPGEN]) == tg, bar);
            __builtin_amdgcn_fence(__ATOMIC_ACQUIRE, "agent");
            xb_add(&bar[XB_XGEN(b.x)], 1u);
            asm volatile("s_waitcnt vmcnt(0)" ::: "memory");
        } else {
            XB_SPIN(xb_ld(&bar[XB_XGEN(b.x)]) == gen, bar);
            __builtin_amdgcn_fence(__ATOMIC_ACQUIRE, "agent");
            asm volatile("s_waitcnt vmcnt(0)" ::: "memory");
        }
    }
    __syncthreads();
}


typedef short s16x4 __attribute__((ext_vector_type(4)));
typedef float f32x2 __attribute__((ext_vector_type(2)));
typedef __bf16 bf16x2v __attribute__((ext_vector_type(2)));
struct Args { const float* in[16]; float* out; unsigned char* ws; int ph_lo, ph_hi; };
#define KARGS() ((const __attribute__((address_space(4))) Args*)__builtin_amdgcn_kernarg_segment_ptr())
#define INP(k) (KARGS()->in[k])
#define OUTP() (KARGS()->out)
struct Frame {
    LAS unsigned char* lds;
    volatile LAS unsigned* MISC;
    gu32* ctl;
    unsigned char* ws;
    int tid, lane, wave, vcu, G;
};
__device__ __forceinline__ unsigned pkbf(float lo, float hi) { const f32x2 v = {lo, hi}; return __builtin_bit_cast(unsigned, __builtin_convertvector(v, bf16x2v)); }
__device__ __forceinline__ float bflo(unsigned u) { return __builtin_bit_cast(float, u << 16); }
__device__ __forceinline__ float bfhi(unsigned u) { return __builtin_bit_cast(float, u & 0xffff0000u); }
__device__ __forceinline__ float wave_sum(float v) {
    v += xshf<1>(v); v += xshf<2>(v); v += xshf<4>(v); v += xshf<8>(v); v += xshf<16>(v); v += xshf<32>(v);
    return v;
}
__device__ __forceinline__ float wave_max(float v) {
    v = fmaxf(v, xshf<1>(v)); v = fmaxf(v, xshf<2>(v)); v = fmaxf(v, xshf<4>(v)); v = fmaxf(v, xshf<8>(v)); v = fmaxf(v, xshf<16>(v)); v = fmaxf(v, xshf<32>(v));
    return v;
}
__device__ __forceinline__ int t5_bucket(int n) {
    if (n < 16) return n;
    return 16 + (n >= 22) + (n >= 30) + (n >= 40) + (n >= 54) + (n >= 73) + (n >= 99) + (n >= 134) + (n >= 182) + (n >= 246) + (n >= 332) + (n >= 450) + (n >= 609) + (n >= 825) + (n >= 1117) + (n >= 1513);
}
__device__ __forceinline__ float softmax_offset(const Frame& F, const float* gq, int ngq, const float* gk, int ngk) {
    float a = 0.f, b = 0.f, c = 0.f;
    for (int i = F.lane; i < ngq; i += 64) a = fmaxf(a, fabsf(gq[i]));
    for (int i = F.lane; i < ngk; i += 64) b = fmaxf(b, fabsf(gk[i]));
    for (int i = F.lane; i < 1024; i += 64) c = fmaxf(c, fabsf(INP(1)[i]));
    return M2_QK * wave_max(a) * wave_max(b) + LOG2E * wave_max(c);
}

struct CvtItem { const float* W; bf16* WT; const float* gain; int K, N, mode, idx; };
constexpr int I_QKV = (D / 64) * (NQKV / 32), I_DD = (D / 64) * (D / 32), I_GU = (D / 64) * (NGU / 32), I_DN = (DFF / 64) * (D / 32), I_KV = (D / 64) * (2 * D / 32);
constexpr int CVT_A_END = I_QKV + I_DD + I_GU + I_DN + I_DD + I_GU;
constexpr int CVT_B_END = CVT_A_END + I_KV + I_DD;
constexpr int CVT_C_END = CVT_B_END + I_DN;
__device__ __forceinline__ CvtItem cvt_describe(const Frame& F, int it) {
    int r = it;
    if (r < I_QKV) return CvtItem{INP(4), (bf16*)(F.ws + WS_WQKV), INP(2), D, NQKV, 0, r}; r -= I_QKV;
    if (r < I_DD) return CvtItem{INP(7), (bf16*)(F.ws + WS_WOA), nullptr, D, D, 0, r}; r -= I_DD;
    if (r < I_GU) return CvtItem{INP(14), (bf16*)(F.ws + WS_WGU), INP(3), D, NGU, 1, r}; r -= I_GU;
    if (r < I_DN) return CvtItem{INP(15), (bf16*)(F.ws + WS_WDN), nullptr, DFF, D, 0, r}; r -= I_DN;
    if (r < I_DD) return CvtItem{INP(13), (bf16*)(F.ws + WS_WOB), nullptr, D, D, 0, r}; r -= I_DD;
    if (r < I_GU) return CvtItem{INP(14) + (size_t)D * NGU, (bf16*)(F.ws + WS_WGU) + (size_t)NGU * D, INP(3) + D, D, NGU, 1, r}; r -= I_GU;
    if (r < I_KV) return CvtItem{INP(9), (bf16*)(F.ws + WS_WKV), INP(8), D, 2 * D, 0, r}; r -= I_KV;
    if (r < I_DD) return CvtItem{INP(11), (bf16*)(F.ws + WS_WQB), INP(2) + D, D, D, 0, r}; r -= I_DD;
    return CvtItem{INP(15) + (size_t)DFF * D, (bf16*)(F.ws + WS_WDN) + (size_t)D * DFF, nullptr, DFF, D, 0, r};
}
__device__ __forceinline__ void cvt_load(const CvtItem& d, int lane, float (&wv)[32]) {
    const int nblk = d.N / 32, kb = d.idx / nblk, nb = d.idx % nblk, k0 = 64 * kb, n0 = 32 * nb;
#pragma unroll
    for (int i = 0; i < 8; ++i) { const f32x4 v = __builtin_nontemporal_load((const GAS f32x4*)(d.W + (size_t)(k0 + 8 * i + (lane >> 3)) * d.N + n0 + 4 * (lane & 7)));
        wv[4 * i] = v[0]; wv[4 * i + 1] = v[1]; wv[4 * i + 2] = v[2]; wv[4 * i + 3] = v[3]; }
}
__device__ __forceinline__ void cvt_store(const CvtItem& d, int lane, const float (&wv)[32], LAS float* scr) {
    const int nblk = d.N / 32, kb = d.idx / nblk, nb = d.idx % nblk, k0 = 64 * kb, n0 = 32 * nb;
#pragma unroll
    for (int i = 0; i < 8; ++i)
#pragma unroll
        for (int j = 0; j < 4; ++j) scr[(8 * i + (lane >> 3)) * 33 + 4 * (lane & 7) + j] = wv[4 * i + j];
    LDS_WAIT(); asm volatile("" ::: "memory");
    int r0 = n0;
    if (d.mode == 1) { const int up = n0 >= DFF, j = up ? n0 - DFF : n0; r0 = 256 * (j >> 7) + (up ? 128 : 0) + (j & 127); }
    const int c = lane & 7;
    f32x4 ga = {1.f, 1.f, 1.f, 1.f}, gb = {1.f, 1.f, 1.f, 1.f};
    if (d.gain != nullptr) { ga = *(const GAS f32x4*)(d.gain + k0 + 8 * c); gb = *(const GAS f32x4*)(d.gain + k0 + 8 * c + 4); }
#pragma unroll
    for (int j = 0; j < 4; ++j) { const int n = (lane >> 3) + 8 * j; const LAS float* s = scr + (8 * c) * 33 + n;
        v4u o; o.x = pkbf(s[0 * 33] * ga[0], s[1 * 33] * ga[1]); o.y = pkbf(s[2 * 33] * ga[2], s[3 * 33] * ga[3]); o.z = pkbf(s[4 * 33] * gb[0], s[5 * 33] * gb[1]); o.w = pkbf(s[6 * 33] * gb[2], s[7 * 33] * gb[3]);
        const int rr = r0 + n;
        __builtin_nontemporal_store(o, (GAS v4u*)(d.WT + ((size_t)(rr >> 8) * (d.K / 64) + kb) * 16384 + (size_t)(rr & 255) * 64 + 8 * c)); }
    LDS_WAIT(); asm volatile("" ::: "memory");
}
__device__ __forceinline__ void convert_items(Frame& F, int lo, int hi, int gw, int NGW) {
    LAS float* scr = (LAS float*)(F.lds + RING_OFF + F.wave * 16384);
    for (int it = lo + gw; it < hi; it += 2 * NGW) {
        const CvtItem a = cvt_describe(F, lo + hi - 1 - it); float wa[32]; cvt_load(a, F.lane, wa);
        const bool hasb = it + NGW < hi;
        if (hasb) { const CvtItem b = cvt_describe(F, lo + hi - 1 - (it + NGW)); float wb[32]; cvt_load(b, F.lane, wb); cvt_store(a, F.lane, wa, scr); cvt_store(b, F.lane, wb, scr); }
        else cvt_store(a, F.lane, wa, scr);
    }
}
__device__ __forceinline__ void cvt_rows(Frame& F, const float* X, bf16* xb, float* pss) {
    const int gw = F.vcu * NWAVES + F.wave, NGW = F.G * NWAVES;
    for (int m = gw; m < S; m += NGW) {
        const GAS f32x4* xr = (const GAS f32x4*)(X + (size_t)m * D) + F.lane;
        f32x4 v[16]; float s = 0.f;
#pragma unroll
        for (int j = 0; j < 16; ++j) { v[j] = xr[64 * j]; s += (v[j].x * v[j].x + v[j].y * v[j].y) + (v[j].z * v[j].z + v[j].w * v[j].w); }
        s = wave_sum(s);
        GAS unsigned long long* o8 = (GAS unsigned long long*)(xb + (size_t)m * D) + F.lane;
#pragma unroll
        for (int j = 0; j < 16; ++j) o8[64 * j] = (unsigned long long)pkbf(v[j].x, v[j].y) | ((unsigned long long)pkbf(v[j].z, v[j].w) << 32);
        if (F.lane < 16) pss[(size_t)m * 16 + F.lane] = F.lane == 0 ? s : 0.f;
    }
}
__device__ __forceinline__ void convert_queue(Frame& F, int lo, int hi, gu32* ctr) {
    LAS float* scr = (LAS float*)(F.lds + RING_OFF + F.wave * 16384);
    constexpr unsigned CH = 16u;
    unsigned c = 0u; if (F.lane == 0) c = __hip_atomic_fetch_add(ctr, CH, __ATOMIC_RELAXED, __HIP_MEMORY_SCOPE_AGENT);
    int base = lo + __builtin_amdgcn_readfirstlane((int)c);
    while (base < hi) {
        unsigned cn = 0u; if (F.lane == 0) cn = __hip_atomic_fetch_add(ctr, CH, __ATOMIC_RELAXED, __HIP_MEMORY_SCOPE_AGENT);
        const int end = base + (int)CH < hi ? base + (int)CH : hi;
        for (int it = base; it < end; it += 2) {
            const CvtItem a = cvt_describe(F, it); float wa[32]; cvt_load(a, F.lane, wa);
            if (it + 1 < end) { const CvtItem b = cvt_describe(F, it + 1); float wb[32]; cvt_load(b, F.lane, wb); cvt_store(a, F.lane, wa, scr); cvt_store(b, F.lane, wb, scr); }
            else cvt_store(a, F.lane, wa, scr);
        }
        base = lo + __builtin_amdgcn_readfirstlane((int)cn);
    }
}
__device__ __forceinline__ void p0_prologue(Frame& F) {
    const int gw = F.vcu * NWAVES + F.wave, NGW = F.G * NWAVES;
    convert_items(F, 0, I_QKV, gw, NGW);
    cvt_rows(F, INP(0), ((bf16*)(F.ws + (WS_HN))), ((float*)(F.ws + (WS_PSS))));
}

constexpr int K_OFF = 0, V_OFF = 65536;
__device__ __forceinline__ unsigned offb(unsigned row, unsigned ch) { return 256u * row + 16u * (ch ^ (((row & 3u) << 2) | ((row >> 2) & 3u))); }
__device__ __forceinline__ void stage_kv(Frame& F, const bf16* kbase, const bf16* vbase, size_t rstride, int first_valid) {
    v4u kr[8], vr[8];
#pragma unroll
    for (int it = 0; it < 8; ++it) { const int idx = F.tid + 512 * it, row = idx >> 4, ch = idx & 15;
        if (row >= first_valid) { kr[it] = *(const GAS v4u*)(kbase + (size_t)row * rstride + ch * 8); vr[it] = *(const GAS v4u*)(vbase + (size_t)row * rstride + ch * 8); }
        else { kr[it] = (v4u){0u, 0u, 0u, 0u}; vr[it] = (v4u){0u, 0u, 0u, 0u}; } }
#pragma unroll
    for (int it = 0; it < 8; ++it) { const int idx = F.tid + 512 * it, row = idx >> 4, ch = idx & 15; const unsigned o = offb(row, ch);
        *(LAS v4u*)(F.lds + K_OFF + o) = kr[it]; *(LAS v4u*)(F.lds + V_OFF + o) = vr[it]; }
}
struct KVR { v4u k[8], v[8]; };
__device__ __forceinline__ void kv_issue(KVR& R, int tid, const bf16* kbase, const bf16* vbase, size_t rstride, int first_valid) {
#pragma unroll
    for (int it = 0; it < 8; ++it) { const int idx = tid + 512 * it, row = idx >> 4, ch = idx & 15;
        if (row >= first_valid) { R.k[it] = *(const GAS v4u*)(kbase + (size_t)row * rstride + ch * 8); R.v[it] = *(const GAS v4u*)(vbase + (size_t)row * rstride + ch * 8); }
        else { R.k[it] = (v4u){0u, 0u, 0u, 0u}; R.v[it] = (v4u){0u, 0u, 0u, 0u}; } }
}
__device__ __forceinline__ void kv_commit(Frame& F, const KVR& R) {
#pragma unroll
    for (int it = 0; it < 8; ++it) { const int idx = F.tid + 512 * it, row = idx >> 4, ch = idx & 15; const unsigned o = offb(row, ch);
        *(LAS v4u*)(F.lds + K_OFF + o) = R.k[it]; *(LAS v4u*)(F.lds + V_OFF + o) = R.v[it]; }
}
struct KVH { v4u k[4], v[4]; };
__device__ __forceinline__ void kvh_issue(KVH& R, int tid, const bf16* kbase, const bf16* vbase, size_t rstride, bool zero) {
#pragma unroll
    for (int it = 0; it < 4; ++it) { const int idx = tid + 512 * it, row = idx >> 4, ch = idx & 15;
        if (!zero) { R.k[it] = *(const GAS v4u*)(kbase + (size_t)row * rstride + ch * 8); R.v[it] = *(const GAS v4u*)(vbase + (size_t)row * rstride + ch * 8); }
        else { R.k[it] = (v4u){0u, 0u, 0u, 0u}; R.v[it] = (v4u){0u, 0u, 0u, 0u}; } }
}
__device__ __forceinline__ void kvh_commit(Frame& F, const KVH& R, int half) {
#pragma unroll
    for (int it = 0; it < 4; ++it) { const int idx = F.tid + 512 * it, row = 128 * half + (idx >> 4), ch = idx & 15; const unsigned o = offb(row, ch);
        *(LAS v4u*)(F.lds + K_OFF + o) = R.k[it]; *(LAS v4u*)(F.lds + V_OFF + o) = R.v[it]; }
}
template <bool CONSTB, class Idx>
__device__ __forceinline__ void attn_pairs(Frame& F, const LAS float* lut, float cbias, const bf16x8 (&qf)[4], int jp0, int npairs, const Idx& idx, f32x4 (&o)[8], float& l, int jx = 0) {
    const int fr = F.lane & 15, fq = F.lane >> 4;
    const int kp = 8 * (fq & 1) + 4 * (fq >> 1);
    const int pr = 8 * ((fr >> 2) & 1) + 4 * (fr >> 3) + (fr & 3);
    const int tq = fr >> 2, tp = fr & 3;
    const LAS unsigned char* kbase = F.lds + K_OFF; const LAS unsigned char* vbase = F.lds + V_OFF;
    const int jlast = jp0 + npairs - 1;
    bf16x8 ka[4], kb[4];
#pragma unroll
    for (int s = 0; s < 4; ++s) { ka[s] = *(const LAS bf16x8*)(kbase + offb(32 * (jp0 ^ jx) + pr, 4 * s + fq)); kb[s] = *(const LAS bf16x8*)(kbase + offb(32 * (jp0 ^ jx) + 16 + pr, 4 * s + fq)); }
#pragma unroll 1
    for (int jp = jp0; jp <= jlast; ++jp) {
        const int ja = 2 * jp, jb = ja + 1;
        const int pa = 2 * (jp ^ jx), pb = pa + 1;
        int ix[8]; float lv[8];
        if (!CONSTB) {
#pragma unroll
            for (int i = 0; i < 4; ++i) { ix[i] = idx(16 * ja + kp + i); ix[4 + i] = idx(16 * jb + kp + i); }
#pragma unroll
            for (int i = 0; i < 8; ++i) lv[i] = lut[ix[i] < 0 ? 0 : ix[i]];
        }
        s16x4 va[4], vb[4], vc[4], vd[4];
#pragma unroll
        for (int dt = 0; dt < 4; ++dt) {
            va[dt] = __builtin_amdgcn_ds_read_tr16_b64_v4i16((LAS s16x4*)(vbase + offb(16 * pa + kp + tq, 2 * dt + (tp >> 1)) + 8 * (tp & 1)));
            vb[dt] = __builtin_amdgcn_ds_read_tr16_b64_v4i16((LAS s16x4*)(vbase + offb(16 * pb + kp + tq, 2 * dt + (tp >> 1)) + 8 * (tp & 1)));
        }
        f32x4 sa = {0.f, 0.f, 0.f, 0.f}, sb = {0.f, 0.f, 0.f, 0.f};
#pragma unroll
        for (int s = 0; s < 4; ++s) {
            sa = __builtin_amdgcn_mfma_f32_16x16x32_bf16(ka[s], qf[s], sa, 0, 0, 0);
            sb = __builtin_amdgcn_mfma_f32_16x16x32_bf16(kb[s], qf[s], sb, 0, 0, 0);
        }
        __builtin_amdgcn_sched_barrier(0);
        const int jn = (jp < jlast ? jp + 1 : jlast) ^ jx;
#pragma unroll
        for (int s = 0; s < 4; ++s) { ka[s] = *(const LAS bf16x8*)(kbase + offb(32 * jn + pr, 4 * s + fq)); kb[s] = *(const LAS bf16x8*)(kbase + offb(32 * jn + 16 + pr, 4 * s + fq)); }
        float p[8];
#pragma unroll
        for (int i = 0; i < 4; ++i) {
            if (CONSTB) { p[i] = __builtin_amdgcn_exp2f(sa[i] + cbias); p[4 + i] = __builtin_amdgcn_exp2f(sb[i] + cbias); }
            else { const float ea = __builtin_amdgcn_exp2f(sa[i] + lv[i]), eb = __builtin_amdgcn_exp2f(sb[i] + lv[4 + i]); p[i] = ix[i] < 0 ? 0.f : ea; p[4 + i] = ix[4 + i] < 0 ? 0.f : eb; }
        }
        l += ((p[0] + p[1]) + (p[2] + p[3])) + ((p[4] + p[5]) + (p[6] + p[7]));
        v4u pw; pw.x = pkbf(p[0], p[1]); pw.y = pkbf(p[2], p[3]); pw.z = pkbf(p[4], p[5]); pw.w = pkbf(p[6], p[7]);
        const bf16x8 pf = __builtin_bit_cast(bf16x8, pw);
#pragma unroll
        for (int dt = 0; dt < 4; ++dt) {
            vc[dt] = __builtin_amdgcn_ds_read_tr16_b64_v4i16((LAS s16x4*)(vbase + offb(16 * pa + kp + tq, 2 * (dt + 4) + (tp >> 1)) + 8 * (tp & 1)));
            vd[dt] = __builtin_amdgcn_ds_read_tr16_b64_v4i16((LAS s16x4*)(vbase + offb(16 * pb + kp + tq, 2 * (dt + 4) + (tp >> 1)) + 8 * (tp & 1)));
        }
#pragma unroll
        for (int dt = 0; dt < 4; ++dt) {
            const bf16x8 vf = __builtin_shufflevector(va[dt], vb[dt], 0, 1, 2, 3, 4, 5, 6, 7);
            o[dt] = __builtin_amdgcn_mfma_f32_16x16x32_bf16(vf, pf, o[dt], 0, 0, 0);
        }
#pragma unroll
        for (int dt = 0; dt < 4; ++dt) {
            const bf16x8 vf = __builtin_shufflevector(vc[dt], vd[dt], 0, 1, 2, 3, 4, 5, 6, 7);
            o[dt + 4] = __builtin_amdgcn_mfma_f32_16x16x32_bf16(vf, pf, o[dt + 4], 0, 0, 0);
        }
    }
}
constexpr float RL_NEG = -1.0e30f;
__device__ __forceinline__ void attn_pairs_rl(Frame& F, const LAS float* rlp, const bf16x8 (&qf)[4], int jp0, int npairs, f32x4 (&o)[8], float& l, int jx = 0) {
    const int fr = F.lane & 15, fq = F.lane >> 4;
    const int kp = 8 * (fq & 1) + 4 * (fq >> 1);
    const int pr = 8 * ((fr >> 2) & 1) + 4 * (fr >> 3) + (fr & 3);
    const int tq = fr >> 2, tp = fr & 3;
    const LAS unsigned char* kbase = F.lds + K_OFF; const LAS unsigned char* vbase = F.lds + V_OFF;
    const int jlast = jp0 + npairs - 1;
    bf16x8 ka[4], kb[4];
#pragma unroll
    for (int s = 0; s < 4; ++s) { ka[s] = *(const LAS bf16x8*)(kbase + offb(32 * (jp0 ^ jx) + pr, 4 * s + fq)); kb[s] = *(const LAS bf16x8*)(kbase + offb(32 * (jp0 ^ jx) + 16 + pr, 4 * s + fq)); }
    f32x4 la, lb;
    { const LAS float* rp = rlp + 32 * jp0;
#pragma unroll
      for (int i = 0; i < 4; ++i) { la[i] = rp[i]; lb[i] = rp[16 + i]; } }
#pragma unroll 1
    for (int jp = jp0; jp <= jlast; ++jp) {
        const int pa = 2 * (jp ^ jx), pb = pa + 1;
        s16x4 va[4], vb[4], vc[4], vd[4];
#pragma unroll
        for (int dt = 0; dt < 4; ++dt) {
            va[dt] = __builtin_amdgcn_ds_read_tr16_b64_v4i16((LAS s16x4*)(vbase + offb(16 * pa + kp + tq, 2 * dt + (tp >> 1)) + 8 * (tp & 1)));
            vb[dt] = __builtin_amdgcn_ds_read_tr16_b64_v4i16((LAS s16x4*)(vbase + offb(16 * pb + kp + tq, 2 * dt + (tp >> 1)) + 8 * (tp & 1)));
        }
        f32x4 sa = la, sb = lb;
#pragma unroll
        for (int s = 0; s < 4; ++s) {
            sa = __builtin_amdgcn_mfma_f32_16x16x32_bf16(ka[s], qf[s], sa, 0, 0, 0);
            sb = __builtin_amdgcn_mfma_f32_16x16x32_bf16(kb[s], qf[s], sb, 0, 0, 0);
        }
        __builtin_amdgcn_sched_barrier(0);
        const int jl = jp < jlast ? jp + 1 : jlast, jn = jl ^ jx;
#pragma unroll
        for (int s = 0; s < 4; ++s) { ka[s] = *(const LAS bf16x8*)(kbase + offb(32 * jn + pr, 4 * s + fq)); kb[s] = *(const LAS bf16x8*)(kbase + offb(32 * jn + 16 + pr, 4 * s + fq)); }
        { const LAS float* rp = rlp + 32 * jl;
#pragma unroll
          for (int i = 0; i < 4; ++i) { la[i] = rp[i]; lb[i] = rp[16 + i]; } }
        float p[8];
#pragma unroll
        for (int i = 0; i < 4; ++i) { p[i] = __builtin_amdgcn_exp2f(sa[i]); p[4 + i] = __builtin_amdgcn_exp2f(sb[i]); }
        l += ((p[0] + p[1]) + (p[2] + p[3])) + ((p[4] + p[5]) + (p[6] + p[7]));
        v4u pw; pw.x = pkbf(p[0], p[1]); pw.y = pkbf(p[2], p[3]); pw.z = pkbf(p[4], p[5]); pw.w = pkbf(p[6], p[7]);
        const bf16x8 pf = __builtin_bit_cast(bf16x8, pw);
#pragma unroll
        for (int dt = 0; dt < 4; ++dt) {
            vc[dt] = __builtin_amdgcn_ds_read_tr16_b64_v4i16((LAS s16x4*)(vbase + offb(16 * pa + kp + tq, 2 * (dt + 4) + (tp >> 1)) + 8 * (tp & 1)));
            vd[dt] = __builtin_amdgcn_ds_read_tr16_b64_v4i16((LAS s16x4*)(vbase + offb(16 * pb + kp + tq, 2 * (dt + 4) + (tp >> 1)) + 8 * (tp & 1)));
        }
#pragma unroll
        for (int dt = 0; dt < 4; ++dt) {
            const bf16x8 vf = __builtin_shufflevector(va[dt], vb[dt], 0, 1, 2, 3, 4, 5, 6, 7);
            o[dt] = __builtin_amdgcn_mfma_f32_16x16x32_bf16(vf, pf, o[dt], 0, 0, 0);
        }
#pragma unroll
        for (int dt = 0; dt < 4; ++dt) {
            const bf16x8 vf = __builtin_shufflevector(vc[dt], vd[dt], 0, 1, 2, 3, 4, 5, 6, 7);
            o[dt + 4] = __builtin_amdgcn_mfma_f32_16x16x32_bf16(vf, pf, o[dt + 4], 0, 0, 0);
        }
    }
}
__device__ __forceinline__ void o_tile_pack(const f32x4 (&o)[8], float sc, int fq, v4u (&w)[4]) {
    const bool odd = (fq & 1) != 0;
#pragma unroll
    for (int p = 0; p < 4; ++p) {
        const unsigned a0 = pkbf(o[2 * p][0] * sc, o[2 * p][1] * sc), a1 = pkbf(o[2 * p][2] * sc, o[2 * p][3] * sc);
        const unsigned b0 = pkbf(o[2 * p + 1][0] * sc, o[2 * p + 1][1] * sc), b1 = pkbf(o[2 * p + 1][2] * sc, o[2 * p + 1][3] * sc);
        const unsigned s0 = odd ? a0 : b0, s1 = odd ? a1 : b1;
        const unsigned r0 = (unsigned)xshf_i<16>((int)s0), r1 = (unsigned)xshf_i<16>((int)s1);
        w[p] = odd ? (v4u){r0, r1, b0, b1} : (v4u){a0, a1, r0, r1};
    }
}
__device__ __forceinline__ int o_tile_off(int fq, int p) { return 32 * p + ((fq & 1) ? 16 + 4 * (fq - 1) : 4 * fq); }
__device__ __forceinline__ void fp8_pack(const f32x4 (&o)[8], float sc, v4u& wa, v4u& wb) {
    int q[8];
#pragma unroll
    for (int dt = 0; dt < 8; ++dt) { int t_ = 0; t_ = __builtin_amdgcn_cvt_pk_fp8_f32(o[dt][0] * sc, o[dt][1] * sc, t_, false); t_ = __builtin_amdgcn_cvt_pk_fp8_f32(o[dt][2] * sc, o[dt][3] * sc, t_, true); q[dt] = t_; }
    wa = (v4u){(unsigned)q[0], (unsigned)q[1], (unsigned)q[2], (unsigned)q[3]}; wb = (v4u){(unsigned)q[4], (unsigned)q[5], (unsigned)q[6], (unsigned)q[7]};
}
__device__ __forceinline__ void fp8_acc1(f32x4& o, float ws, unsigned dw) {
    const f32x2 lo = __builtin_amdgcn_cvt_pk_f32_fp8((int)dw, false), hi = __builtin_amdgcn_cvt_pk_f32_fp8((int)dw, true);
    o[0] += ws * lo[0]; o[1] += ws * lo[1]; o[2] += ws * hi[0]; o[3] += ws * hi[1];
}
__device__ __forceinline__ void fp8_acc(f32x4 (&o)[8], float ws, const v4u& pa, const v4u& pb) {
    fp8_acc1(o[0], ws, pa.x); fp8_acc1(o[1], ws, pa.y); fp8_acc1(o[2], ws, pa.z); fp8_acc1(o[3], ws, pa.w);
    fp8_acc1(o[4], ws, pb.x); fp8_acc1(o[5], ws, pb.y); fp8_acc1(o[6], ws, pb.z); fp8_acc1(o[7], ws, pb.w);
    asm volatile("" : "+v"(o[0]), "+v"(o[1]), "+v"(o[2]), "+v"(o[3]), "+v"(o[4]), "+v"(o[5]), "+v"(o[6]), "+v"(o[7]));
}
__device__ __forceinline__ void load_qf(const bf16* qrow, int fq, bf16x8 (&qf)[4]) {
#pragma unroll
    for (int s = 0; s < 4; ++s) qf[s] = *(const GAS bf16x8*)(qrow + 32 * s + 8 * fq);
}

__device__ __forceinline__ const bf16* hm_row(const Frame& F, int slot, long t) { return (const bf16*)(F.ws + WS_PROJ) + ((size_t)slot * S + t) * HD; }
__device__ __forceinline__ void load_bias_table(Frame& F, float M2) {
    LAS float* bt = (LAS float*)(F.lds + BIAS_OFF);
    for (int i = F.tid; i < 32 * NH; i += 512) bt[i] = INP(1)[i] * LOG2E - M2;
}
__device__ __forceinline__ void p_dilated(Frame& F) {
    const float M2 = softmax_offset(F, INP(5), 3 * HD, INP(6), HD);
    LAS float* lut = (LAS float*)(F.lds + X_OFF);
    const LAS float* bt = (const LAS float*)(F.lds + BIAS_OFF);
    load_bias_table(F, M2);
    __syncthreads();
    const int fr = F.lane & 15, fq = F.lane >> 4, w = F.wave;
    for (int p = F.vcu; p < 8 * NH; p += F.G) {
        const int h = p >> 3, i = p & 7;
#pragma unroll 1
        for (int cc = 0; cc < 4; ++cc) {
            const int g = cc < 2 ? cc : 2, dsh = 2 * g;
            const int r = cc == 0 ? 0 : (cc == 1 ? (i >> 1) : 2 * i + (cc - 2));
            const int b0 = cc == 0 ? 8 * i : (cc == 1 ? 8 * (i & 1) : 0), nblk = cc < 2 ? 8 : 4;
            const size_t rstride = (size_t)HD << dsh;
            const int kslot = 96 + h, vslot = 128 + h, qslot = 32 * g + h;
            KVH A, B;
            kvh_issue(A, F.tid, hm_row(F, kslot, ((long)(128 * b0) << dsh) + r), hm_row(F, vslot, ((long)(128 * b0) << dsh) + r), rstride, false);
            kvh_issue(B, F.tid, hm_row(F, kslot, ((long)(128 * (b0 - 1)) << dsh) + r), hm_row(F, vslot, ((long)(128 * (b0 - 1)) << dsh) + r), rstride, b0 == 0);
            bf16x8 qn[4]; load_qf(hm_row(F, qslot, ((long)(128 * b0 + 16 * w + fr) << dsh) + r), fq, qn);
            __syncthreads();
            kvh_commit(F, A, 0); kvh_commit(F, B, 1);
            if (F.tid < 384) { const int dist = 255 - F.tid; lut[F.tid] = (dist >= 0 && dist <= 128) ? bt[t5_bucket(dist << dsh) * NH + h] : RL_NEG; }
#pragma unroll 1
            for (int b = b0; b < b0 + nblk; ++b) {
                __syncthreads();
                const bool more = b + 1 < b0 + nblk;
                if (more) kvh_issue(A, F.tid, hm_row(F, kslot, ((long)(128 * (b + 1)) << dsh) + r), hm_row(F, vslot, ((long)(128 * (b + 1)) << dsh) + r), rstride, false);
                bf16x8 qf[4];
#pragma unroll
                for (int s = 0; s < 4; ++s) qf[s] = qn[s];
                if (more) load_qf(hm_row(F, qslot, ((long)(128 * (b + 1) + 16 * w + fr) << dsh) + r), fq, qn);
                const int iq = 16 * w + fr;
                const long tq = ((long)(128 * b + iq) << dsh) + r;
                f32x4 o[8];
#pragma unroll
                for (int dt = 0; dt < 8; ++dt) o[dt] = (f32x4){0.f, 0.f, 0.f, 0.f};
                float l = 0.f;
                const int jp0 = (b == 0) ? 4 : (w >> 1);
                attn_pairs_rl(F, lut + (127 - iq + 8 * (fq & 1) + 4 * (fq >> 1)), qf, jp0, (w >> 1) + 5 - jp0, o, l, (b & 1) ? 0 : 4);
                l += xshf<16>(l); l += xshf<32>(l);
                unsigned char* po = (unsigned char*)(F.ws + WS_PART) + ((size_t)(g * NH + h) * S + tq) * 128 + 16 * fq;
                { v4u wa, wb; fp8_pack(o, 1.0f / l, wa, wb); *(GAS v4u*)(po) = wa; *(GAS v4u*)(po + 64) = wb; }
                if (fq == 0) ((float*)(F.ws + (WS_LPART)))[(size_t)(g * NH + h) * S + tq] = l;
                if (more) { __syncthreads();
                    kvh_commit(F, A, (b + 1) & 1); }
            }
        }
    }
    __syncthreads();
}
__device__ __forceinline__ void p_merge3(Frame& F) {
    const int fr = F.lane & 15, fq = F.lane >> 4;
    const unsigned char* part = (const unsigned char*)(F.ws + WS_PART); const float* lp = (const float*)(F.ws + WS_LPART);
    constexpr size_t GROW = (size_t)NH * S;
    constexpr int NIT = NH * S / 16;
    const int step = F.G * 8;
    int it = F.vcu * 8 + F.wave;
    v4u a0, b0, a1, b1, a2, b2; float l0, l1, l2;
#define M3_LOAD(IT) { const size_t ht_ = (size_t)(IT) * 16 + fr; const unsigned char* p_ = part + ht_ * 128 + 16 * fq; \
        l0 = lp[ht_]; l1 = lp[GROW + ht_]; l2 = lp[2 * GROW + ht_]; \
        a0 = *(const GAS v4u*)(p_); b0 = *(const GAS v4u*)(p_ + 64); a1 = *(const GAS v4u*)(p_ + GROW * 128); b1 = *(const GAS v4u*)(p_ + GROW * 128 + 64); \
        a2 = *(const GAS v4u*)(p_ + 2 * GROW * 128); b2 = *(const GAS v4u*)(p_ + 2 * GROW * 128 + 64); }
    if (it < NIT) M3_LOAD(it)
    for (; it < NIT; it += step) {
        const size_t ht = (size_t)it * 16 + fr;
        f32x4 o[8];
#pragma unroll
        for (int dt = 0; dt < 8; ++dt) o[dt] = (f32x4){0.f, 0.f, 0.f, 0.f};
        const float inv = 1.0f / (l0 + l1 + l2);
        fp8_acc(o, l0, a0, b0); fp8_acc(o, l1, a1, b1); fp8_acc(o, l2, a2, b2);
        if (it + step < NIT) M3_LOAD(it + step)
        bf16* po = ((bf16*)(F.ws + (WS_OB))) + ht * HD;
        v4u wv[4]; o_tile_pack(o, inv, fq, wv);
#pragma unroll
        for (int p = 0; p < 4; ++p) *(GAS v4u*)(po + o_tile_off(fq, p)) = wv[p];
    }
#undef M3_LOAD
}
__device__ __forceinline__ void top3_insert(float v, unsigned i, float& v0, float& v1, float& v2, unsigned& i0, unsigned& i1, unsigned& i2) {
    const bool g0 = v > v0 || (v == v0 && i < i0), g1 = v > v1 || (v == v1 && i < i1), g2 = v > v2 || (v == v2 && i < i2);
    const float n2 = g1 ? v1 : (g2 ? v : v2), n1 = g0 ? v0 : (g1 ? v : v1), n0 = g0 ? v : v0;
    const unsigned j2 = g1 ? i1 : (g2 ? i : i2), j1 = g0 ? i0 : (g1 ? i : i1), j0 = g0 ? i : i0;
    v0 = n0; v1 = n1; v2 = n2; i0 = j0; i1 = j1; i2 = j2;
}
__device__ __forceinline__ void p_gate(Frame& F) {
    constexpr int KH_OFF = 0, KL_OFF = 8192;
    const int fr = F.lane & 15, fq = F.lane >> 4, w = F.wave;
    const float NEGV = -3.0e38f;
    constexpr int NU = 32 * NH;
    int hcur = -1;
    bf16x8 hf[2][4], lf[2][4];
    int u = F.vcu;
    bf16x8 qn[4];
    if (u < NU) load_qf(hm_row(F, 64 + u % NH, 256 * (u / NH) + 32 * w + fr), fq, qn);
    for (int st = 0; u < NU; ++st) {
        const int c = u / NH, h = u % NH, qt = st & 1;
        if (h != hcur) {
            __syncthreads();
            { const int n = F.tid >> 4, ch = F.tid & 15;
              const GAS f32x4* src = (const GAS f32x4*)(((float*)(F.ws + (WS_KMEAN))) + (size_t)n * D + h * HD + 8 * ch);
              const f32x4 a = src[0], b = src[1];
              unsigned hi[4], lo[4];
              hi[0] = pkbf(a[0], a[1]); hi[1] = pkbf(a[2], a[3]); hi[2] = pkbf(b[0], b[1]); hi[3] = pkbf(b[2], b[3]);
              lo[0] = pkbf(a[0] - bflo(hi[0]), a[1] - bfhi(hi[0])); lo[1] = pkbf(a[2] - bflo(hi[1]), a[3] - bfhi(hi[1]));
              lo[2] = pkbf(b[0] - bflo(hi[2]), b[1] - bfhi(hi[2])); lo[3] = pkbf(b[2] - bflo(hi[3]), b[3] - bfhi(hi[3]));
              const unsigned o = offb(n, ch);
              *(LAS v4u*)(F.lds + KH_OFF + o) = (v4u){hi[0], hi[1], hi[2], hi[3]}; *(LAS v4u*)(F.lds + KL_OFF + o) = (v4u){lo[0], lo[1], lo[2], lo[3]}; }
            __syncthreads();
#pragma unroll
            for (int s = 0; s < 4; ++s) {
                hf[0][s] = *(const LAS bf16x8*)(F.lds + KH_OFF + offb(fr, 4 * s + fq)); hf[1][s] = *(const LAS bf16x8*)(F.lds + KH_OFF + offb(16 + fr, 4 * s + fq));
                lf[0][s] = *(const LAS bf16x8*)(F.lds + KL_OFF + offb(fr, 4 * s + fq)); lf[1][s] = *(const LAS bf16x8*)(F.lds + KL_OFF + offb(16 + fr, 4 * s + fq)); }
            hcur = h;
        }
        const int t = 256 * c + 32 * w + 16 * qt + fr;
        bf16x8 qf[4];
#pragma unroll
        for (int s = 0; s < 4; ++s) qf[s] = qn[s];
        const int un = qt ? u + F.G : u;
        if (un < NU) load_qf(hm_row(F, 64 + un % NH, 256 * (un / NH) + 32 * w + 16 * (qt ^ 1) + fr), fq, qn);
        f32x4 g0 = {0.f, 0.f, 0.f, 0.f}, g1 = {0.f, 0.f, 0.f, 0.f};
#pragma unroll
        for (int s = 0; s < 4; ++s) {
            g0 = __builtin_amdgcn_mfma_f32_16x16x32_bf16(hf[0][s], qf[s], g0, 0, 0, 0); g0 = __builtin_amdgcn_mfma_f32_16x16x32_bf16(lf[0][s], qf[s], g0, 0, 0, 0);
            g1 = __builtin_amdgcn_mfma_f32_16x16x32_bf16(hf[1][s], qf[s], g1, 0, 0, 0); g1 = __builtin_amdgcn_mfma_f32_16x16x32_bf16(lf[1][s], qf[s], g1, 0, 0, 0);
        }
        float v0 = NEGV, v1 = NEGV, v2 = NEGV; unsigned i0 = 0xffu, i1 = 0xffu, i2 = 0xffu;
#pragma unroll
        for (int i = 0; i < 4; ++i) { const int na = 4 * fq + i, nb = 16 + 4 * fq + i;
            top3_insert(na < c ? g0[i] : NEGV, na < c ? (unsigned)na : 0xffu, v0, v1, v2, i0, i1, i2);
            top3_insert(nb < c ? g1[i] : NEGV, nb < c ? (unsigned)nb : 0xffu, v0, v1, v2, i0, i1, i2); }
#define GATE_MERGE(M) { const float pv0 = xshf<M>(v0), pv1 = xshf<M>(v1), pv2 = xshf<M>(v2); \
            const unsigned pi0 = (unsigned)xshf_i<M>((int)i0), pi1 = (unsigned)xshf_i<M>((int)i1), pi2 = (unsigned)xshf_i<M>((int)i2); \
            top3_insert(pv0, pi0, v0, v1, v2, i0, i1, i2); top3_insert(pv1, pi1, v0, v1, v2, i0, i1, i2); top3_insert(pv2, pi2, v0, v1, v2, i0, i1, i2); }
        GATE_MERGE(16) GATE_MERGE(32)
#undef GATE_MERGE
        if (fq == 0) ((unsigned*)(F.ws + (WS_SEL)))[(size_t)h * S + t] = i0 | (i1 << 8) | (i2 << 16) | 0xff000000u;
        u = un;
    }
    __syncthreads();
}
__constant__ unsigned char PB_ITEMS[54][3] = {{7,8,20},{0,3,7},{2,3,7},{9,10,25},{1,5,12},{4,5,12},{0,7,17},{2,7,17},{6,7,17},{3,9,22},{8,9,22},{10,11,27},{1,2,5},{5,6,14},{3,4,9},{1,12,28},{4,12,28},{11,12,28},{12,13,29},{5,14,30},{13,14,30},{14,15,31},{15,16,32},{0,1,3},{0,17,32},{2,17,32},{6,17,32},{16,17,32},{17,18,32},{18,19,32},{7,20,32},{19,20,32},{20,21,32},{3,22,32},{8,22,32},{21,22,32},{22,23,32},{23,24,32},{9,25,32},{24,25,32},{25,26,32},{10,27,32},{26,27,32},{1,28,32},{4,28,32},{11,28,32},{27,28,32},{12,29,32},{28,29,32},{5,30,32},{13,30,32},{29,30,32},{14,31,32},{30,31,32}};
__constant__ unsigned char PB_CLASS[8][7] = {{0,17,16,31,35,45,51},{2,13,18,29,33,43,255},{1,14,15,30,34,44,49},{3,12,22,26,36,46,47},{5,9,23,27,32,48,53},{4,11,21,25,39,40,255},{8,6,19,28,37,42,50},{7,10,20,24,38,41,52}};
constexpr int N_PB = 54, PB_NSEL = 8;
__device__ __forceinline__ void build_lut_moba(Frame& F, int h, int n) {
    LAS float* lut = (LAS float*)(F.lds + X_OFF);
    const LAS float* bt = (const LAS float*)(F.lds + BIAS_OFF);
    for (int i = F.tid; i < n; i += 512) lut[i] = bt[t5_bucket(i) * NH + h];
}
constexpr int RL_CP = 1791;
__device__ __forceinline__ void build_rl_own(Frame& F, int h) {
    LAS float* rl = (LAS float*)(F.lds + X_OFF);
    const LAS float* bt = (const LAS float*)(F.lds + BIAS_OFF);
    { const int i = F.tid, dist = 255 - i; rl[i] = dist >= 0 ? bt[t5_bucket(dist) * NH + h] : RL_NEG; }
}
__device__ __forceinline__ void build_rl_past(Frame& F, int h) {
    LAS float* rl = (LAS float*)(F.lds + X_OFF);
    const LAS float* bt = (const LAS float*)(F.lds + BIAS_OFF);
    for (int i = F.tid; i < 2048; i += 512) { const int dist = RL_CP - i; rl[i] = bt[t5_bucket(dist < 0 ? 0 : dist) * NH + h]; }
}
struct PbItem { int h, n, c_lo, c_hi; };
__device__ __forceinline__ PbItem pb_decode(int it) { PbItem x; const int k = it / NH; x.h = it % NH; x.n = PB_ITEMS[k][0]; x.c_lo = PB_ITEMS[k][1]; x.c_hi = PB_ITEMS[k][2]; return x; }
__device__ __forceinline__ void pb_issue(Frame& F, const PbItem& x, KVR& R) {
    kv_issue(R, F.tid, hm_row(F, x.h, 256 * x.n), hm_row(F, 32 + x.h, 256 * x.n), (size_t)HD, 0);
}
__device__ __forceinline__ void pb_sel(Frame& F, const PbItem& x, unsigned (&selr)[PB_NSEL]) {
    const int ncand = 256 * (x.c_hi - x.c_lo);
#pragma unroll
    for (int k = 0; k < PB_NSEL; ++k) { const int i = F.tid + 512 * k; selr[k] = i < ncand ? ((const unsigned*)(F.ws + WS_SEL))[(size_t)x.h * S + 256 * x.c_lo + i] : 0xffffffffu; }
}
template <int VAR>
__device__ __forceinline__ void p_past(Frame& F) {
    const float M2 = softmax_offset(F, INP(12), HD, INP(10), HD);
    LAS float* lut = (LAS float*)(F.lds + X_OFF);
    LAS unsigned short* list = (LAS unsigned short*)(F.lds + LIST_OFF);
    LAS unsigned* cntp = (LAS unsigned*)(F.lds + LDSCTL_OFF);
    const int fr = F.lane & 15, fq = F.lane >> 4;
    constexpr int NI = N_PB * NH;
    const bool packed = (F.G == 256);
    auto item_at = [&](int j) -> int { if (!packed) { const int i = F.vcu + j * F.G; return i < NI ? i : -1; }
        if (j >= 7) return -1; const int k = PB_CLASS[F.vcu >> 5][j]; return k == 255 ? -1 : k * NH + (F.vcu & 31); };
    int js = 0; int it = item_at(0);
    load_bias_table(F, M2);
    __syncthreads();
    build_rl_past(F, F.vcu % NH);
    const LAS float* btc = (const LAS float*)(F.lds + BIAS_OFF);
    KVR R;
    if (it >= 0) pb_issue(F, pb_decode(it), R);
    for (; it >= 0; it = item_at(++js)) {
        const PbItem x = pb_decode(it);
        const int h = x.h, n = x.n;
        unsigned selr[PB_NSEL]; pb_sel(F, x, selr);
        if (F.tid == 0) *cntp = 0u;
        kv_commit(F, R);
        if (h != F.vcu % NH) build_rl_past(F, h);
        __syncthreads();
        const int ncand = 256 * (x.c_hi - x.c_lo);
#pragma unroll
        for (int k = 0; k < PB_NSEL; ++k) {
            if (512 * k < ncand) {
                const int i = F.tid + 512 * k; const unsigned s = selr[k];
                const int slot = (i >= ncand) ? -1 : (((s & 0xffu) == (unsigned)n) ? 0 : ((((s >> 8) & 0xffu) == (unsigned)n) ? 1 : ((((s >> 16) & 0xffu) == (unsigned)n) ? 2 : -1)));
                const unsigned long long mask = __ballot(slot >= 0);
                unsigned base = 0u;
                if (F.lane == 0 && mask != 0ull) base = __hip_atomic_fetch_add(cntp, (unsigned)__popcll(mask), __ATOMIC_RELAXED, __HIP_MEMORY_SCOPE_WORKGROUP);
                base = (unsigned)__builtin_amdgcn_readfirstlane((int)base);
                if (slot >= 0) list[base + (unsigned)__popcll(mask & ((1ull << F.lane) - 1ull))] = (unsigned short)((unsigned)i | ((unsigned)slot << 13));
            }
        }
        __syncthreads();
        const int cnt = (int)*cntp, ntile = (cnt + 15) >> 4;
        int ti = F.wave;
        unsigned entn = 0u; bf16x8 qn[4];
        const int tb0 = 256 * x.c_lo;
        if (ti < ntile) { const int e = 16 * ti + fr; entn = list[e < cnt ? e : 0]; load_qf(hm_row(F, 64 + h, (long)(tb0 + (int)(entn & 0x1fffu))), fq, qn); }
        while (ti < ntile) {
            const unsigned ent = entn; const bool valid = (16 * ti + fr) < cnt;
            bf16x8 qf[4];
#pragma unroll
            for (int s = 0; s < 4; ++s) qf[s] = qn[s];
            const int tn = ti + NWAVES;
            if (tn < ntile) { const int e = 16 * tn + fr; entn = list[e < cnt ? e : 0]; load_qf(hm_row(F, 64 + h, (long)(tb0 + (int)(entn & 0x1fffu))), fq, qn); }
            const int t = tb0 + (int)(ent & 0x1fffu), slot = (int)(ent >> 13);
            f32x4 o[8];
#pragma unroll
            for (int dt = 0; dt < 8; ++dt) o[dt] = (f32x4){0.f, 0.f, 0.f, 0.f};
            float l = 0.f;
            const int tbase = t - 256 * n;
            if (VAR != 3) { const int jb = RL_CP - tbase; attn_pairs_rl(F, lut + ((jb < 0 ? 0 : jb) + 8 * (fq & 1) + 4 * (fq >> 1)), qf, 0, 8, o, l); }
            else { l = __builtin_bit_cast(float, (int)qf[0][0] + (int)qf[1][1] + (int)qf[2][2] + (int)qf[3][3]); }
            l += xshf<16>(l); l += xshf<32>(l);
            if (valid && (VAR != 2 || l == 12345.678f)) {
                int fqo = fq; asm volatile("" : "+v"(fqo));
                const float invl = 1.0f / l;
                v4u wa, wb;
                { int q0 = 0, q1 = 0, q2 = 0, q3 = 0, q4 = 0, q5 = 0, q6 = 0, q7 = 0;
#define FP8_DW(q, dt) q = __builtin_amdgcn_cvt_pk_fp8_f32(o[dt][0] * invl, o[dt][1] * invl, q, false); q = __builtin_amdgcn_cvt_pk_fp8_f32(o[dt][2] * invl, o[dt][3] * invl, q, true);
                  FP8_DW(q0, 0) FP8_DW(q1, 1) FP8_DW(q2, 2) FP8_DW(q3, 3) FP8_DW(q4, 4) FP8_DW(q5, 5) FP8_DW(q6, 6) FP8_DW(q7, 7)
#undef FP8_DW
                  wa = (v4u){(unsigned)q0, (unsigned)q1, (unsigned)q2, (unsigned)q3}; wb = (v4u){(unsigned)q4, (unsigned)q5, (unsigned)q6, (unsigned)q7}; }
                unsigned char* po = (unsigned char*)(F.ws + WS_PART) + ((size_t)(slot * NH + h) * S + t) * 128 + 32 * fqo;
                *(GAS v4u*)(po) = wa; *(GAS v4u*)(po + 16) = wb;
                if (fq == 0) ((float*)(F.ws + (WS_LPART)))[(size_t)(slot * NH + h) * S + t] = l;
            }
            ti = tn;
        }
        { const int itn = item_at(js + 1); if (itn >= 0) pb_issue(F, pb_decode(itn), R); }
        __syncthreads();
    }
}
__device__ __forceinline__ void own_issue(Frame& F, int u, KVR& R) {
    const int c = u / NH, h = u % NH;
    kv_issue(R, F.tid, hm_row(F, h, 256 * c), hm_row(F, 32 + h, 256 * c), (size_t)HD, 0);
}
__device__ __forceinline__ void p_own(Frame& F) {
    const float M2 = softmax_offset(F, INP(12), HD, INP(10), HD);
    LAS float* lut = (LAS float*)(F.lds + X_OFF);
    const int fr = F.lane & 15, fq = F.lane >> 4, w = F.wave;
    constexpr int NU = 32 * NH;
    int u = F.vcu;
    load_bias_table(F, M2);
    __syncthreads();
    build_rl_own(F, F.vcu % NH);
    KVR R;
    if (u < NU) own_issue(F, u, R);
    for (; u < NU; u += F.G) {
        const int c = u / NH, h = u % NH;
        kv_commit(F, R);
        if (h != F.vcu % NH) build_rl_own(F, h);
        __syncthreads();
        const int nslot = c < 3 ? c : 3;
        bf16x8 qa[4], qbf[4];
        load_qf(hm_row(F, 64 + h, 256 * c + 16 * w + fr), fq, qa);
#pragma unroll
        for (int pass = 0; pass < 2; ++pass) {
            const int qt = pass == 0 ? w : 15 - w, iq = 16 * qt + fr, t = 256 * c + iq;
            f32x4 o[8];
#pragma unroll
            for (int dt = 0; dt < 8; ++dt) o[dt] = (f32x4){0.f, 0.f, 0.f, 0.f};
            float l = 0.f;
            const LAS float* rlp = lut + (255 - iq + 8 * (fq & 1) + 4 * (fq >> 1));
            if (pass == 0) attn_pairs_rl(F, rlp, qa, 0, (qt >> 1) + 1, o, l); else attn_pairs_rl(F, rlp, qbf, 0, (qt >> 1) + 1, o, l);
            l += xshf<16>(l); l += xshf<32>(l);
            if (pass == 0) load_qf(hm_row(F, 64 + h, 256 * c + 16 * (15 - w) + fr), fq, qbf);
            v4u pa[3], pb[3]; float lp[3];
#pragma unroll
            for (int s = 0; s < 3; ++s) {
                if (s < nslot) { lp[s] = ((const float*)(F.ws + WS_LPART))[(size_t)(s * NH + h) * S + t];
                    const unsigned char* p = (const unsigned char*)(F.ws + WS_PART) + ((size_t)(s * NH + h) * S + t) * 128 + 32 * fq;
                    pa[s] = *(const GAS v4u*)(p); pb[s] = *(const GAS v4u*)(p + 16); }
                else { lp[s] = 0.f; pa[s] = (v4u){0u, 0u, 0u, 0u}; pb[s] = (v4u){0u, 0u, 0u, 0u}; }
            }
#pragma unroll
            for (int s = 0; s < 3; ++s) { l += lp[s]; const float ws = lp[s];
#define FP8_ACC(dw, dt) { const int q_ = (int)(dw); const f32x2 lo_ = __builtin_amdgcn_cvt_pk_f32_fp8(q_, false), hi_ = __builtin_amdgcn_cvt_pk_f32_fp8(q_, true); o[dt][0] += ws * lo_[0]; o[dt][1] += ws * lo_[1]; o[dt][2] += ws * hi_[0]; o[dt][3] += ws * hi_[1]; }
                FP8_ACC(pa[s].x, 0) FP8_ACC(pa[s].y, 1) FP8_ACC(pa[s].z, 2) FP8_ACC(pa[s].w, 3) FP8_ACC(pb[s].x, 4) FP8_ACC(pb[s].y, 5) FP8_ACC(pb[s].z, 6) FP8_ACC(pb[s].w, 7)
                asm volatile("" : "+v"(o[0]), "+v"(o[1]), "+v"(o[2]), "+v"(o[3]), "+v"(o[4]), "+v"(o[5]), "+v"(o[6]), "+v"(o[7]));
#undef FP8_ACC
            }
            const float inv = 1.0f / l;
            bf16* po = ((bf16*)(F.ws + (WS_OB))) + ((size_t)h * S + t) * HD;
            { v4u wv[4]; o_tile_pack(o, inv, fq, wv);
#pragma unroll
              for (int p = 0; p < 4; ++p) *(GAS v4u*)(po + o_tile_off(fq, p)) = wv[p]; }
        }
        if (u + F.G < NU) own_issue(F, u + F.G, R);
        __syncthreads();
    }
}
#ifndef EN_P0
#define EN_P0 1
#endif
#ifndef EN_P1
#define EN_P1 1
#endif
#ifndef EN_P2
#define EN_P2 1
#endif
#ifndef EN_P3
#define EN_P3 1
#endif
#ifndef EN_P8
#define EN_P8 1
#endif
#ifndef EN_P9
#define EN_P9 1
#endif
#ifndef EN_P10
#define EN_P10 1
#endif
#ifndef EN_P11
#define EN_P11 1
#endif
#ifndef EN_P12
#define EN_P12 1
#endif
#ifndef EN_PWO
#define EN_PWO 1
#endif
#ifndef EN_PN
#define EN_PN 1
#endif
#ifndef EN_PGU
#define EN_PGU 1
#endif
#ifndef EN_PDN
#define EN_PDN 1
#endif


#if defined(PROBE_GEMM) || defined(PROBE_INLINE_GEMM)
namespace pg8 {
struct EpiNull { static constexpr bool PERM = true, AFTER_DRAIN = false, INIT_BASE = false; bf16_t* O;
    __device__ __forceinline__ void operator()(const f32x4 (&acc)[2][2][4][2], const Unit& u, int wr, int wc, int fr, int fq) const {
        float s = 0.f;
#pragma unroll
        for (int ai = 0; ai < 2; ++ai)
#pragma unroll
            for (int bj = 0; bj < 2; ++bj)
#pragma unroll
                for (int m = 0; m < 4; ++m)
#pragma unroll
                    for (int n = 0; n < 2; ++n) s += acc[ai][bj][m][n][0] + acc[ai][bj][m][n][1] + acc[ai][bj][m][n][2] + acc[ai][bj][m][n][3];
        if (s == 12345.678f) O[u.pm * 7 + u.pn] = 1; } };
struct EpiPlain { static constexpr bool PERM = true, AFTER_DRAIN = false, INIT_BASE = false; bf16_t* O; int ldc;
    __device__ __forceinline__ void operator()(const f32x4 (&acc)[2][2][4][2], const Unit& u, int wr, int wc, int fr, int fq) const {
        const int row0 = u.pm * BM + wr * 64 + fr, col0 = u.pn * BM + wc * 32 + 8 * fq;
#pragma unroll
        for (int ai = 0; ai < 2; ++ai)
#pragma unroll
            for (int m = 0; m < 4; ++m) { bf16_t* rowp = O + (size_t)(row0 + ai * HALF + m * 16) * ldc + col0;
#pragma unroll
                for (int bj = 0; bj < 2; ++bj) { const f32x4 v0 = acc[ai][bj][m][0], v1 = acc[ai][bj][m][1];
                    u32x4 w; w.x = cvt_pk_bf16(v0[0], v0[1]); w.y = cvt_pk_bf16(v0[2], v0[3]); w.z = cvt_pk_bf16(v1[0], v1[1]); w.w = cvt_pk_bf16(v1[2], v1[3]);
                    *(u32x4*)(rowp + bj * HALF) = w; } } } };
}
#endif
#ifdef PROBE_GEMM
template <int V>
__global__ void __launch_bounds__(NWAVES * 64, 2) probe_gemm(Args args) {
    extern __shared__ __attribute__((aligned(16))) unsigned char lds[];
    LAS unsigned char* ring = (LAS unsigned char*)lds;
    unsigned char* ws = args.ws;
    pg8::Gemm g{(bf16*)(ws + WS_HN), (bf16*)(ws + WS_WQKV), S, NQKV, D}; pg8::StaticOrder So; So.init(S, NQKV, gridDim.x, (int)blockIdx.x);
    if (V == 0) { pg8::EpiNull E{(bf16*)(ws + WS_PROJ)}; pg8::gemm_phase<pg8::EpiNull, pg8::StaticOrder, true, true>(ring, g, So, E); }
    if (V == 1) { pg8::EpiPlain E{(bf16*)(ws + WS_PROJ), NQKV}; pg8::gemm_phase<pg8::EpiPlain, pg8::StaticOrder, true, true>(ring, g, So, E); }
    if (V == 2) { pg8::EpiNull E{(bf16*)(ws + WS_PROJ)}; pg8::gemm_phase<pg8::EpiNull, pg8::StaticOrder, false, true>(ring, g, So, E); }
    if (V == 3) { pg8::EpiPlain E{(bf16*)(ws + WS_PROJ), NQKV}; pg8::gemm_phase<pg8::EpiPlain, pg8::StaticOrder, false, true>(ring, g, So, E); }
}
#define XG(V) { static bool once_g##V = false; if (!once_g##V) { once_g##V = true; (void)hipFuncSetAttribute((const void*)probe_gemm<V>, hipFuncAttributeMaxDynamicSharedMemorySize, LDS_BYTES); } \
    hipLaunchKernelGGL((probe_gemm<V>), dim3(grid), dim3(NWAVES * 64), LDS_BYTES, stream, a); }
#endif
template <int PH_LO, int PH_HI>
__global__ void __launch_bounds__(NWAVES * 64, 2) yoco_fwd(Args args) {
    extern __shared__ __attribute__((aligned(16))) unsigned char lds[];
    Frame F;
    F.lds = (LAS unsigned char*)lds;
    F.MISC = (volatile LAS unsigned*)(F.lds + MISC_OFF);
    F.tid = threadIdx.x; F.lane = F.tid & 63; F.wave = __builtin_amdgcn_readfirstlane(F.tid >> 6);
    F.G = gridDim.x; { const int bx = blockIdx.x; F.vcu = (F.G % 8 == 0) ? (bx % 8) * (F.G / 8) + bx / 8 : bx; }
    unsigned char* ws = args.ws; F.ws = ws;
    F.ctl = (gu32*)(ws + WS_CTL);
    for (int u = F.tid; u < (LDS_BYTES - LDSCTL_OFF) / 4; u += NWAVES * 64) ((LAS unsigned*)(F.lds + LDSCTL_OFF))[u] = 0u;
    __syncthreads();
    XcdBarrier bar; bar.bar = (unsigned*)(F.ctl + CW_BAR); bar.x = 0; bar.st = nullptr;
    if (PH_HI - PH_LO > 1) bar = xcd_barrier_post((unsigned*)(F.ctl + CW_BAR), F.MISC + 8);
#ifdef PROBE_DOUBLE_BAR
#define GRID_BAR() do { if (PH_HI - PH_LO > 1) { xcd_barrier(bar); xcd_barrier(bar); } } while (0)
#else
#define GRID_BAR() do { if (PH_HI - PH_LO > 1) xcd_barrier(bar); } while (0)
#endif
    constexpr int lo = PH_LO, hi = PH_HI;
#define IN(k) (lo <= (k) && (k) < hi)
#define NEXTP(k) (((k) == 4 || (k) == 7 || (k) == 13) ? (k) + 2 : (k) + 1)
#define SEAM(k) do { if (IN(k) && IN(NEXTP(k))) GRID_BAR(); } while (0)
    LAS unsigned char* ring = F.lds + RING_OFF;
#define PHF(P) Frame P = F; { int t_ = F.tid; asm volatile("" : "+v"(t_)); t_ &= 511; P.tid = t_; P.lane = t_ & 63; }
    LAS float* xch = (LAS float*)(F.lds + X_OFF);
    LAS float* rtab = (LAS float*)(F.lds + LIST_OFF);
#define RT_RESET() do { if (F.tid == 0) rtab[0] = __int_as_float(-1); } while (0)

    if (EN_P0 && IN(0)) { PHF(P) p0_prologue(P); }
#ifdef PROBE_DOUBLE_P0
    GRID_BAR(); { PHF(P) p0_prologue(P); }
#endif
    SEAM(0);
    if (EN_P1 && IN(1)) {
        pg8::Gemm g{((bf16*)(F.ws + (WS_HN))), ((bf16*)(F.ws + (WS_WQKV))), S, NQKV, D}; pg8::RangeOrder So; So.init(S, NQKV, F.G, (int)blockIdx.x);
        pg8::EpiHeadNorm E{((bf16*)(F.ws + (WS_PROJ))), S, 0, 48, 4, 48, 16, INP(5), INP(6), QSCALE, nullptr, xch, ((float*)(F.ws + (WS_PSS))), rtab}; RT_RESET();
        const int ksplit = (10 * ((int)blockIdx.x & 7) + 3) / 7;
#pragma unroll 1
        for (int part = 0; part < 2; ++part) {
            So.i0 = part ? ksplit : 0; So.i1 = part ? (1 << 20) : ksplit;
            pg8::gemm_phase<pg8::EpiHeadNorm, pg8::RangeOrder, true, true>(ring, g, So, E);
            if (part == 0) { { PHF(P) convert_items(P, I_QKV, CVT_A_END, P.vcu * NWAVES + P.wave, P.G * NWAVES); } __syncthreads(); }
        }
#ifdef PROBE_DOUBLE_P1
        GRID_BAR(); RT_RESET(); So.i0 = 0; pg8::gemm_phase<pg8::EpiHeadNorm, pg8::RangeOrder, true, true>(ring, g, So, E);
#endif
        } SEAM(1);
#ifdef PROBE_INLINE_GEMM
    { GRID_BAR(); pg8::Gemm g{((bf16*)(F.ws + (WS_HN))), ((bf16*)(F.ws + (WS_WQKV))), S, PROBE_INLINE_GEMM, D}; pg8::StaticOrder So; So.init(S, PROBE_INLINE_GEMM, F.G, (int)blockIdx.x);
      pg8::EpiNull E{((bf16*)(F.ws + (WS_HID)))}; pg8::gemm_phase<pg8::EpiNull, pg8::StaticOrder, true, true>(ring, g, So, E); }
#endif
    if (EN_P2 && IN(2)) { PHF(P) p_dilated(P); }
#ifdef PROBE_DOUBLE_P2
    GRID_BAR(); { PHF(P) p_dilated(P); }
#endif
    SEAM(2);
    if (EN_P3 && IN(3)) { PHF(P) p_merge3(P); }
#ifdef PROBE_DOUBLE_P3
    GRID_BAR(); { PHF(P) p_merge3(P); }
#endif
    SEAM(3);
#ifdef PROBE_DOUBLE_GU
#define PROBE_REP_GU GRID_BAR(); RT_RESET(); pg8::gemm_phase<pg8::EpiSwiGLU, pg8::StaticOrder, true, true>(ring, g, So, E);
#else
#define PROBE_REP_GU
#endif
#define LAYER_TAIL(l) { const int pb = l ? 13 : 4; \
        if (EN_PWO && IN(pb)) { pg8::Gemm g{((bf16*)(F.ws + (WS_OB))), l ? ((bf16*)(F.ws + (WS_WOB))) : ((bf16*)(F.ws + (WS_WOA))), S, D, D}; pg8::StaticOrder So; So.init(S, D, F.G, (int)blockIdx.x); \
            pg8::EpiResNorm E{((bf16*)(F.ws + (WS_HN))), D, nullptr, ((float*)(F.ws + (WS_PSS))), xch}; \
            pg8::gemm_phase<pg8::EpiResNorm, pg8::StaticOrder, true, true, true>(ring, g, So, E); } SEAM(pb); \
        if (EN_PGU && IN(pb + 2)) { const int nhlp = 0;     \
            if ((int)blockIdx.x >= F.G - nhlp) { PHF(P) convert_items(P, CVT_B_END, CVT_C_END, ((int)blockIdx.x - (F.G - nhlp)) * NWAVES + P.wave, nhlp * NWAVES); } \
            else { pg8::Gemm g{((bf16*)(F.ws + (WS_HN))), ((bf16*)(F.ws + (WS_WGU))) + (size_t)l * NGU * D, S, NGU, D}; pg8::StaticOrder So; So.init(S, NGU, F.G - nhlp, (int)blockIdx.x); \
            pg8::EpiSwiGLU E{((bf16*)(F.ws + (WS_HID))), DFF, ((float*)(F.ws + (WS_PSS))), rtab}; RT_RESET(); \
            pg8::gemm_phase<pg8::EpiSwiGLU, pg8::StaticOrder, true, true>(ring, g, So, E); PROBE_REP_GU } \
            { PHF(P) convert_queue(P, l ? CVT_B_END : CVT_A_END, l ? CVT_C_END : CVT_B_END, F.ctl + (l ? CW_CVTC : CW_CVTB)); } } SEAM(pb + 2); \
        if (EN_PDN && IN(pb + 3)) { pg8::Gemm g{((bf16*)(F.ws + (WS_HID))), ((bf16*)(F.ws + (WS_WDN))) + (size_t)l * D * DFF, S, D, DFF}; pg8::StaticOrder So; So.init(S, D, F.G, (int)blockIdx.x); \
            pg8::EpiResNorm E{((bf16*)(F.ws + (WS_HN))), D, l ? OUTP() : (float*)nullptr, ((float*)(F.ws + (WS_PSS))), xch}; \
            pg8::gemm_phase<pg8::EpiResNorm, pg8::StaticOrder, true, true>(ring, g, So, E); } }
    LAYER_TAIL(0)
    SEAM(7);
    if (EN_P9 && IN(9)) { pg8::Gemm g{((bf16*)(F.ws + (WS_HN))), ((bf16*)(F.ws + (WS_WKV))), S, 3 * D, D}; pg8::StaticOrder So; So.init(S, 3 * D, F.G, (int)blockIdx.x);
        pg8::EpiHeadNorm E{((bf16*)(F.ws + (WS_PROJ))), S, 32, 16, 31, 0, 16, INP(12), INP(10), QSCALE, ((float*)(F.ws + (WS_KMEAN))), xch, ((float*)(F.ws + (WS_PSS))), rtab}; RT_RESET();
        pg8::gemm_phase<pg8::EpiHeadNorm, pg8::StaticOrder, true, true>(ring, g, So, E);
#ifdef PROBE_DOUBLE_P9
        GRID_BAR(); RT_RESET(); pg8::gemm_phase<pg8::EpiHeadNorm, pg8::StaticOrder, true, true>(ring, g, So, E);
#endif
        } SEAM(9);
    if (EN_P10 && IN(10)) { PHF(P) p_gate(P); }
#ifdef PROBE_DOUBLE_GATE
    GRID_BAR(); { PHF(P) p_gate(P); } GRID_BAR(); { PHF(P) p_gate(P); } GRID_BAR(); { PHF(P) p_gate(P); } GRID_BAR(); { PHF(P) p_gate(P); }
#endif
    SEAM(10);
#ifdef PROBE_P11_VARIANT
    if (EN_P11 && IN(11)) { { PHF(P) p_past<PROBE_P11_VARIANT>(P); } GRID_BAR(); }
#endif
    if (EN_P11 && IN(11)) { PHF(P) p_past<0>(P); } SEAM(11);
    if (EN_P12 && IN(12)) { PHF(P) p_own(P); }
#ifdef PROBE_DOUBLE_P12
    GRID_BAR(); { PHF(P) p_own(P); }
#endif
    SEAM(12);
    LAYER_TAIL(1)
#undef LAYER_TAIL
#undef PHF
#undef RT_RESET
#undef IN
#undef SEAM
#undef NEXTP
#undef GRID_BAR
}

extern "C" void kernel_launch(void* const* d_in, const int* in_sizes, int n_in, void* d_out, int out_size, void* d_ws, size_t ws_size, hipStream_t stream) {
    static int grid = 0;
    if (grid == 0) {
        if (n_in != 16 || in_sizes[0] != S * D || out_size != S * D || ws_size < WS_END) { fprintf(stderr, "kernel_launch: shape/workspace mismatch: n_in %d in0 %d out %d ws %zu (need %zu)\n", n_in, n_in > 0 ? in_sizes[0] : -1, out_size, ws_size, (size_t)WS_END); grid = -1; return; }
        int dev = 0, cus = 0, per_cu = 0;
        if (hipGetDevice(&dev) != hipSuccess || hipDeviceGetAttribute(&cus, hipDeviceAttributeMultiprocessorCount, dev) != hipSuccess) { fprintf(stderr, "kernel_launch: device query failed\n"); grid = -1; return; }
#if MK_PER_PHASE
        hipError_t fe = hipSuccess;
#define SETATTR(P) if (fe == hipSuccess) fe = hipFuncSetAttribute((const void*)yoco_fwd<P, P + 1>, hipFuncAttributeMaxDynamicSharedMemorySize, LDS_BYTES);
        SETATTR(0) SETATTR(1) SETATTR(2) SETATTR(3) SETATTR(4) SETATTR(5) SETATTR(6) SETATTR(7) SETATTR(8) SETATTR(9) SETATTR(10) SETATTR(11) SETATTR(12) SETATTR(13) SETATTR(14) SETATTR(15) SETATTR(16)
#undef SETATTR
        if (fe != hipSuccess) { fprintf(stderr, "kernel_launch: hipFuncSetAttribute failed\n"); grid = -1; return; }
#else
        if (hipFuncSetAttribute((const void*)yoco_fwd<0, N_PHASES>, hipFuncAttributeMaxDynamicSharedMemorySize, LDS_BYTES) != hipSuccess) { fprintf(stderr, "kernel_launch: hipFuncSetAttribute failed\n"); grid = -1; return; }
        if (hipOccupancyMaxActiveBlocksPerMultiprocessor(&per_cu, (const void*)yoco_fwd<0, N_PHASES>, NWAVES * 64, LDS_BYTES) != hipSuccess || per_cu < 1)
            fprintf(stderr, "kernel_launch: note: occupancy query reports %d workgroups per CU\n", per_cu);
#endif
        (void)hipGetLastError();
        grid = cus;
    }
    if (grid < 0) return;
    if (hipMemsetAsync((char*)d_ws + WS_CTL, 0, CTL_ZERO_BYTES, stream) != hipSuccess) { fprintf(stderr, "kernel_launch: memset failed\n"); return; }
    Args a{};
    for (int i = 0; i < 16; ++i) a.in[i] = (const float*)d_in[i];
    a.out = (float*)d_out; a.ws = (unsigned char*)d_ws;
#if MK_PER_PHASE
#define LAUNCH(P) hipLaunchKernelGGL((yoco_fwd<P, P + 1>), dim3(grid), dim3(NWAVES * 64), LDS_BYTES, stream, a);
    LAUNCH(0) LAUNCH(1) LAUNCH(2) LAUNCH(3) LAUNCH(4) LAUNCH(5) LAUNCH(6) LAUNCH(7) LAUNCH(8) LAUNCH(9) LAUNCH(10) LAUNCH(11) LAUNCH(12) LAUNCH(13) LAUNCH(14) LAUNCH(15) LAUNCH(16)
#undef LAUNCH
#else
    hipLaunchKernelGGL((yoco_fwd<0, N_PHASES>), dim3(grid), dim3(NWAVES * 64), LDS_BYTES, stream, a);
#endif
#ifdef PROBE_GEMM
    PROBE_GEMM
#endif
#ifdef PROBE_EXTRA
#define XL(P) { static bool once_##P = false; if (!once_##P) { once_##P = true; (void)hipFuncSetAttribute((const void*)yoco_fwd<P, P + 1>, hipFuncAttributeMaxDynamicSharedMemorySize, LDS_BYTES); } \
    hipLaunchKernelGGL((yoco_fwd<P, P + 1>), dim3(grid), dim3(NWAVES * 64), LDS_BYTES, stream, a); }
#ifdef PROBE_FLAG
    a.ph_lo = PROBE_FLAG;
#endif
    PROBE_EXTRA
#undef XL
#endif
    const hipError_t le = hipPeekAtLastError();
    if (le != hipSuccess) fprintf(stderr, "kernel_launch: launch failed: %s\n", hipGetErrorName(le));
}
```

```cpp
#include <hip/hip_runtime.h>
#include <cstdio>
#include <cstdint>
template <int M> __device__ __forceinline__ int xshf_i(int v) {
    if constexpr (M < 32) return __builtin_amdgcn_ds_swizzle(v, (M << 10) | 0x1f);
    else { const auto r = __builtin_amdgcn_permlane32_swap(v, v, false, false); return (int)((__builtin_amdgcn_mbcnt_hi(~0u, __builtin_amdgcn_mbcnt_lo(~0u, 0u)) < 32u) ? r[1] : r[0]); }
}
template <int M> __device__ __forceinline__ float xshf(float v) { return __builtin_bit_cast(float, xshf_i<M>(__builtin_bit_cast(int, v))); }
namespace pg8 {
#define PG8_LAS __attribute__((address_space(3)))
typedef unsigned short bf16_t;
typedef short bf16x8 __attribute__((ext_vector_type(8)));
typedef float f32x4 __attribute__((ext_vector_type(4)));
typedef unsigned u32x4 __attribute__((ext_vector_type(4)));
constexpr int BM = 256, BK = 64, HALF = 128, HTB = HALF * BK * 2  , STAGE_BYTES = 8 * HTB, NXCD = 8, WGM = 8;

__host__ __device__ __forceinline__ int lds_byte(int r, int c) { const int st = (r >> 4) * 2 + (c >> 5), rr = r & 15, cc = c & 31, ob = rr * 64 + cc * 2; return st * 1024 + (ob ^ (((ob >> 9) & 1) << 5)); }
__host__ __device__ __forceinline__ void stage_rc(int b, int& R, int& C) { const int st = b / 1024, sb = b % 1024, swz = sb ^ (((sb >> 9) & 1) << 5); R = (st >> 1) * 16 + swz / 64; C = (st & 1) * 32 + (swz % 64) / 2; }
__host__ __device__ __forceinline__ int perm32(int rho) { const int n = rho >> 4, i = rho & 15; return 8 * (i >> 2) + 4 * n + (i & 3); }

struct Unit { int pm, pn; };
struct Gemm { const bf16_t* A; const bf16_t* Bt; int M, N, K; };

struct StaticOrder {
    int nM, nN, nwg, G, c;
    __host__ __device__ void init(int M, int N, int G_, int c_) { nM = M / BM; nN = N / BM; nwg = nM * nN; G = G_; c = c_; }
    __host__ __device__ bool next(int i, Unit& u) const {
        const long L = (long)i * G + c; if (L >= nwg) return false;
        int wgid = (int)L; { const int q = nwg / NXCD, r = nwg % NXCD, xcd = wgid % NXCD, off = wgid / NXCD; wgid = (xcd < r ? xcd * (q + 1) : r * (q + 1) + (xcd - r) * q) + off; }
        const int nig = WGM * nN, gid = wgid / nig, fm = gid * WGM, gsz = (nM - fm) < WGM ? (nM - fm) : WGM;
        u.pm = fm + ((wgid % nig) % gsz); u.pn = (wgid % nig) / gsz; return true;
    }
    __device__ __forceinline__ void a_ready(const Unit&) const {}
    __device__ __forceinline__ void done(const Unit&) const {}
};

struct RangeOrder : StaticOrder {
    int i0, i1;
    __host__ __device__ bool next(int i, Unit& u) const { return (i0 + i < i1) && StaticOrder::next(i0 + i, u); }
};

__device__ __forceinline__ unsigned cvt_pk_bf16(float lo, float hi) { unsigned r; asm volatile("v_cvt_pk_bf16_f32 %0, %1, %2" : "=v"(r) : "v"(lo), "v"(hi)); return r; }
typedef float f32x2 __attribute__((ext_vector_type(2)));

constexpr float RMS_EPS = 1e-6f;

#ifndef STORE_POLICY
#define STORE_POLICY 0
#endif
__device__ __forceinline__ void st16(void* p, u32x4 v) {
#if STORE_POLICY == 1
    asm volatile("global_store_dwordx4 %0, %1, off sc1" :: "v"(p), "v"(v) : "memory");
#elif STORE_POLICY == 2
    __builtin_nontemporal_store(v, (u32x4*)p);
#else
    *(u32x4*)p = v;
#endif
}
__device__ __forceinline__ void st16f(void* p, f32x4 v) { st16(p, __builtin_bit_cast(u32x4, v)); }

__device__ __forceinline__ void rstd_panel(PG8_LAS float* rt, const float* pss, int pm, int tid) {
    if (__builtin_amdgcn_readfirstlane(__float_as_int(rt[0])) != pm) {
        asm volatile("s_waitcnt lgkmcnt(0)" ::: "memory"); __builtin_amdgcn_s_barrier(); asm volatile("" ::: "memory");
        if (tid < BM) { const f32x4* p = (const f32x4*)(pss + (size_t)(pm * BM + tid) * 16);
            const f32x4 a = p[0], b = p[1], c = p[2], d = p[3];
            const float s = (((a[0] + a[1]) + (a[2] + a[3])) + ((b[0] + b[1]) + (b[2] + b[3]))) + (((c[0] + c[1]) + (c[2] + c[3])) + ((d[0] + d[1]) + (d[2] + d[3])));
            rt[1 + tid] = __builtin_amdgcn_rsqf(s * (1.0f / 4096.0f) + RMS_EPS); }
        if (tid == 0) rt[0] = __int_as_float(pm);
        asm volatile("s_waitcnt lgkmcnt(0)" ::: "memory"); __builtin_amdgcn_s_barrier(); asm volatile("" ::: "memory");
    }
}
struct EpiHeadNorm {
    static constexpr bool PERM = true, AFTER_DRAIN = false, INIT_BASE = false;
    bf16_t* O; int ldc; int q0, n_q, q_shift, k0, n_k; const float* gq; const float* gk; float qscale; float* kmean; PG8_LAS float* X; const float* pss; PG8_LAS float* rt;
    __device__ __forceinline__ void operator()(const f32x4 (&acc0)[2][2][4][2], const Unit& u, int wr, int wc, int fr, int fq) const {
        const int pn = u.pn, row0 = u.pm * BM + wr * 64 + fr;
        const bool isq = (pn >= q0) && (pn < q0 + n_q), isk = (pn >= k0) && (pn < k0 + n_k);
        bf16_t* Ob = O + (size_t)(2 * pn) * ldc * 128 + wc * 32 + 8 * fq; const size_t hstr = (size_t)ldc * 128;
        rstd_panel(rt, pss, u.pm, (wr * 4 + wc) * 64 + fq * 16 + fr);
        f32x4 acc[2][2][4][2];
#pragma unroll
        for (int ai = 0; ai < 2; ++ai)
#pragma unroll
            for (int m = 0; m < 4; ++m) { const float rr = rt[1 + ai * HALF + wr * 64 + m * 16 + fr];
#pragma unroll
                for (int bj = 0; bj < 2; ++bj) { acc[ai][bj][m][0] = acc0[ai][bj][m][0] * rr; acc[ai][bj][m][1] = acc0[ai][bj][m][1] * rr; } }
        if (!isq && !isk) {
#pragma unroll
            for (int ai = 0; ai < 2; ++ai)
#pragma unroll
                for (int m = 0; m < 4; ++m) { bf16_t* rowp = Ob + (size_t)(row0 + ai * HALF + m * 16) * 128;
#pragma unroll
                    for (int bj = 0; bj < 2; ++bj) { const f32x4 v0 = acc[ai][bj][m][0], v1 = acc[ai][bj][m][1];
                        u32x4 w; w.x = cvt_pk_bf16(v0[0], v0[1]); w.y = cvt_pk_bf16(v0[2], v0[3]); w.z = cvt_pk_bf16(v1[0], v1[1]); w.w = cvt_pk_bf16(v1[2], v1[3]);
                        st16(rowp + bj * hstr, w); } }
            return;
        }
        const float* g = isq ? gq + ((pn - q0) >> q_shift) * 128 : gk;
        const float sc = isq ? qscale : 1.f;
#pragma unroll
        for (int ai = 0; ai < 2; ++ai)
#pragma unroll
            for (int bj = 0; bj < 2; ++bj)
#pragma unroll
                for (int m = 0; m < 4; ++m) { const f32x4 a = acc[ai][bj][m][0], b = acc[ai][bj][m][1];
                    float s = ((a[0] * a[0] + a[1] * a[1]) + (a[2] * a[2] + a[3] * a[3])) + ((b[0] * b[0] + b[1] * b[1]) + (b[2] * b[2] + b[3] * b[3]));
                    s += xshf<16>(s); s += xshf<32>(s);
                    if (fq == 0) X[((ai * HALF + wr * 64 + m * 16 + fr) * 2 + bj) * 4 + wc] = s; }
        asm volatile("s_waitcnt lgkmcnt(0)" ::: "memory"); __builtin_amdgcn_s_barrier(); asm volatile("" ::: "memory");
        const f32x4 g0 = *(const f32x4*)(g + wc * 32 + 8 * fq), g1 = *(const f32x4*)(g + wc * 32 + 8 * fq + 4);
        f32x4 cs[2][2];
#pragma unroll
        for (int bj = 0; bj < 2; ++bj) { cs[bj][0] = (f32x4){0.f, 0.f, 0.f, 0.f}; cs[bj][1] = (f32x4){0.f, 0.f, 0.f, 0.f}; }
#pragma unroll
        for (int ai = 0; ai < 2; ++ai)
#pragma unroll
            for (int m = 0; m < 4; ++m) { bf16_t* rowp = Ob + (size_t)(row0 + ai * HALF + m * 16) * 128;
#pragma unroll
                for (int bj = 0; bj < 2; ++bj) { const f32x4 p = *(const PG8_LAS f32x4*)(X + ((ai * HALF + wr * 64 + m * 16 + fr) * 2 + bj) * 4);
                    const float rs = __builtin_amdgcn_rsqf(((p[0] + p[1]) + (p[2] + p[3])) * (1.0f / 128.0f) + RMS_EPS) * sc;
                    const f32x4 v0 = acc[ai][bj][m][0] * rs * g0, v1 = acc[ai][bj][m][1] * rs * g1;
                    cs[bj][0] += v0; cs[bj][1] += v1;
                    u32x4 w; w.x = cvt_pk_bf16(v0[0], v0[1]); w.y = cvt_pk_bf16(v0[2], v0[3]); w.z = cvt_pk_bf16(v1[0], v1[1]); w.w = cvt_pk_bf16(v1[2], v1[3]);
                    st16(rowp + bj * hstr, w); } }
        if (kmean != nullptr && !isq) {
#pragma unroll
            for (int bj = 0; bj < 2; ++bj)
#pragma unroll
                for (int n = 0; n < 2; ++n)
#pragma unroll
                    for (int j = 0; j < 4; ++j) { float s = cs[bj][n][j];
                        s += xshf<1>(s); s += xshf<2>(s); s += xshf<4>(s); s += xshf<8>(s);
                        if (fr == 0) atomicAdd(kmean + (size_t)u.pm * 4096 + (pn - k0) * BM + bj * HALF + wc * 32 + 8 * fq + 4 * n + j, s * (1.0f / 256.0f)); }
        }
    }
};
struct EpiResNorm {
    static constexpr bool PERM = true, AFTER_DRAIN = false, INIT_BASE = true;
    bf16_t* XB; int ldc; float* outf; float* PSS; PG8_LAS float* X;
    __device__ __forceinline__ void init(f32x4 (&acc)[2][2][4][2], const Unit& u, int wr, int wc, int fr, int fq) const {
        const int row0 = u.pm * BM + wr * 64 + fr, col0 = u.pn * BM + wc * 32 + 8 * fq;
        u32x4 raw[2][4][2];
#pragma unroll
        for (int ai = 0; ai < 2; ++ai)
#pragma unroll
            for (int m = 0; m < 4; ++m)
#pragma unroll
                for (int bj = 0; bj < 2; ++bj) raw[ai][m][bj] = *(const u32x4*)(XB + (size_t)(row0 + ai * HALF + m * 16) * ldc + col0 + bj * HALF);
#pragma unroll
        for (int ai = 0; ai < 2; ++ai)
#pragma unroll
            for (int m = 0; m < 4; ++m)
#pragma unroll
                for (int bj = 0; bj < 2; ++bj) { const u32x4 r = raw[ai][m][bj];
                    acc[ai][bj][m][0] = (f32x4){__uint_as_float(r.x << 16), __uint_as_float(r.x & 0xffff0000u), __uint_as_float(r.y << 16), __uint_as_float(r.y & 0xffff0000u)};
                    acc[ai][bj][m][1] = (f32x4){__uint_as_float(r.z << 16), __uint_as_float(r.z & 0xffff0000u), __uint_as_float(r.w << 16), __uint_as_float(r.w & 0xffff0000u)}; }
    }
    __device__ __forceinline__ void operator()(const f32x4 (&acc)[2][2][4][2], const Unit& u, int wr, int wc, int fr, int fq) const {
        const int row0 = u.pm * BM + wr * 64 + fr, col0 = u.pn * BM + wc * 32 + 8 * fq;
#pragma unroll
        for (int ai = 0; ai < 2; ++ai)
#pragma unroll
            for (int m = 0; m < 4; ++m) { const size_t off = (size_t)(row0 + ai * HALF + m * 16) * ldc + col0;
                float ss = 0.f;
#pragma unroll
                for (int bj = 0; bj < 2; ++bj) { const f32x4 v0 = acc[ai][bj][m][0], v1 = acc[ai][bj][m][1];
                    if (outf != nullptr) { st16f(outf + off + bj * HALF, v0); st16f(outf + off + bj * HALF + 4, v1); }
                    else { ss += ((v0[0] * v0[0] + v0[1] * v0[1]) + (v0[2] * v0[2] + v0[3] * v0[3])) + ((v1[0] * v1[0] + v1[1] * v1[1]) + (v1[2] * v1[2] + v1[3] * v1[3]));
                        u32x4 w; w.x = cvt_pk_bf16(v0[0], v0[1]); w.y = cvt_pk_bf16(v0[2], v0[3]); w.z = cvt_pk_bf16(v1[0], v1[1]); w.w = cvt_pk_bf16(v1[2], v1[3]);
                        st16(XB + off + bj * HALF, w); } }
                if (outf == nullptr) { ss += xshf<16>(ss); ss += xshf<32>(ss); if (fq == 0) X[(ai * HALF + wr * 64 + m * 16 + fr) * 4 + wc] = ss; } }
        if (outf == nullptr) {
            asm volatile("s_waitcnt lgkmcnt(0)" ::: "memory"); __builtin_amdgcn_s_barrier(); asm volatile("" ::: "memory");
            const int t = (wr * 4 + wc) * 64 + fq * 16 + fr;
            if (t < BM) { const f32x4 p = *(const PG8_LAS f32x4*)(X + t * 4); PSS[(size_t)(u.pm * BM + t) * 16 + u.pn] = (p[0] + p[1]) + (p[2] + p[3]); }
        }
    }
};
struct EpiSwiGLU {
    static constexpr bool PERM = true, AFTER_DRAIN = false, INIT_BASE = false;
    bf16_t* H; int ldh; const float* pss; PG8_LAS float* rt;
    static __device__ __forceinline__ f32x4 sw4(const f32x4 g, const f32x4 up, const f32x2 rs) {
        const f32x4 t = g * rs[0];
        f32x4 d = {__builtin_amdgcn_exp2f(t[0]), __builtin_amdgcn_exp2f(t[1]), __builtin_amdgcn_exp2f(t[2]), __builtin_amdgcn_exp2f(t[3])};
        d = d + 1.0f;
        f32x4 r = {__builtin_amdgcn_rcpf(d[0]), __builtin_amdgcn_rcpf(d[1]), __builtin_amdgcn_rcpf(d[2]), __builtin_amdgcn_rcpf(d[3])};
        r = r * rs[1];
        return (g * up) * r;
    }
    __device__ __forceinline__ void operator()(const f32x4 (&acc)[2][2][4][2], const Unit& u, int wr, int wc, int fr, int fq) const {
        const int row0 = u.pm * BM + wr * 64 + fr, col0 = u.pn * HALF + wc * 32 + 8 * fq;
        rstd_panel(rt, pss, u.pm, (wr * 4 + wc) * 64 + fq * 16 + fr);
#pragma unroll
        for (int ai = 0; ai < 2; ++ai)
#pragma unroll
            for (int m = 0; m < 4; ++m) { const float rr = rt[1 + ai * HALF + wr * 64 + m * 16 + fr];
                const f32x2 rs = {rr * -1.4426950408889634f, rr * rr};
                const f32x4 ha = sw4(acc[ai][0][m][0], acc[ai][1][m][0], rs), hb = sw4(acc[ai][0][m][1], acc[ai][1][m][1], rs);
                u32x4 w; w.x = cvt_pk_bf16(ha[0], ha[1]); w.y = cvt_pk_bf16(ha[2], ha[3]); w.z = cvt_pk_bf16(hb[0], hb[1]); w.w = cvt_pk_bf16(hb[2], hb[3]);
                st16(H + (size_t)(row0 + ai * HALF + m * 16) * ldh + col0, w); }
    }
};

template <class Epi, class Sched, bool ALIGN_EPI = false, bool SP2 = false, bool A_HM = false, bool B_BLK = true>
__device__ __forceinline__ void gemm_phase(PG8_LAS unsigned char* lds, const Gemm g, const Sched& S, const Epi& E) {
    int tid_ = threadIdx.x; asm volatile("" : "+v"(tid_)); tid_ &= 511;
    const int tid = tid_, wid = __builtin_amdgcn_readfirstlane(tid >> 6), lane = tid & 63, wr = wid >> 2, wc = wid & 3, fr = lane & 15, fq = lane >> 4;
    const int K = g.K, nt = K / BK;
    unsigned voffA[2], voffB[2];
#pragma unroll
    for (int i = 0; i < 2; ++i) { int R, C; stage_rc(tid * 16 + i * 8192, R, C); const int Rb = Epi::PERM ? ((R & ~31) + perm32(R & 31)) : R;
        voffA[i] = (unsigned)(R * (A_HM ? 128 : K) + C) * 2u; voffB[i] = (unsigned)(Rb * (B_BLK ? 64 : K) + C) * 2u; }
    const size_t kstep = (size_t)(BK * 2);
    const size_t hstep = (size_t)HALF * K * 2;
    const size_t tstep = 2 * hstep;
    const size_t hstepA = A_HM ? (size_t)HALF * 256 : hstep, tstepA = 2 * hstepA, headA = (size_t)g.M * 256;
    const size_t kstepB = B_BLK ? (size_t)32768 : kstep, hstepB = B_BLK ? (size_t)16384 : hstep;
#define PG8_AK(t) (A_HM ? (size_t)((t) >> 1) * headA + (size_t)((t) & 1) * 128 : (size_t)(t) * kstep)
    const unsigned ldsw = (unsigned)wid * 1024u;
    const int aoff = lds_byte(wr * 64 + fr, fq * 8), boff = lds_byte(wc * 32 + fr, fq * 8);
#define PG8_SA(b, h) (((b) * 2 + (h)) * HTB)
#define PG8_SB(b, h) ((4 + (b) * 2 + (h)) * HTB)
#define PG8_STAGE(bufoff, gbase, voff) do { _Pragma("unroll") for (int _i = 0; _i < 2; ++_i) \
        __builtin_amdgcn_global_load_lds((const unsigned*)((const char*)(gbase) + (voff)[_i]), (PG8_LAS unsigned*)(lds + (bufoff) + ldsw + _i * 8192), 16, 0, 0); } while (0)
#define PG8_LDA(dst, b, h) do { _Pragma("unroll") for (int m = 0; m < 4; ++m) _Pragma("unroll") for (int k = 0; k < 2; ++k) dst[m][k] = *(const PG8_LAS bf16x8*)(lds + PG8_SA(b, h) + aoff + m * 2048 + k * 1024); } while (0)
#define PG8_LDB(dst, b, h) do { _Pragma("unroll") for (int n = 0; n < 2; ++n) _Pragma("unroll") for (int k = 0; k < 2; ++k) dst[n][k] = *(const PG8_LAS bf16x8*)(lds + PG8_SB(b, h) + boff + n * 2048 + k * 1024); } while (0)
#define PG8_MMA(ai, bj, At, Bt) do { __builtin_amdgcn_s_setprio(1); _Pragma("unroll") for (int m = 0; m < 4; ++m) _Pragma("unroll") for (int n = 0; n < 2; ++n) _Pragma("unroll") for (int k = 0; k < 2; ++k) \
        acc[ai][bj][m][n] = __builtin_amdgcn_mfma_f32_16x16x32_bf16(Bt[n][k], At[m][k], acc[ai][bj][m][n], 0, 0, 0); __builtin_amdgcn_s_setprio(0); } while (0)
#define PG8_WAIT_V(n) asm volatile("s_waitcnt vmcnt(" #n ")" ::: "memory")
#define PG8_WAIT_L(n) asm volatile("s_waitcnt lgkmcnt(" #n ")" ::: "memory")
#define PG8_BAR __builtin_amdgcn_s_barrier()
#define PG8_SCHED __builtin_amdgcn_sched_barrier(0)
#define PG8_ACC_INIT(U) do { if constexpr (Epi::INIT_BASE) { E.init(acc, (U), wr, wc, fr, fq); \
        _Pragma("unroll") for (int a = 0; a < 2; ++a) _Pragma("unroll") for (int b = 0; b < 2; ++b) _Pragma("unroll") for (int m = 0; m < 4; ++m) _Pragma("unroll") for (int n = 0; n < 2; ++n) asm volatile("" : "+v"(acc[a][b][m][n])); } \
    else { _Pragma("unroll") for (int a = 0; a < 2; ++a) _Pragma("unroll") for (int b = 0; b < 2; ++b) _Pragma("unroll") for (int m = 0; m < 4; ++m) _Pragma("unroll") for (int n = 0; n < 2; ++n) acc[a][b][m][n] = (f32x4){0.f, 0.f, 0.f, 0.f}; } } while (0)
    Unit cur, nxt; int ui = 0;
    if (!S.next(0, cur)) return;
    f32x4 acc[2][2][4][2];
    PG8_ACC_INIT(cur);
    bf16x8 At[4][2], B0[2][2], B1[2][2];
    const char* cA = (const char*)g.A + (size_t)cur.pm * tstepA; const char* cB = (const char*)g.Bt + (size_t)cur.pn * tstep;
    S.a_ready(cur);
    if constexpr (SP2) {
        PG8_STAGE(PG8_SB(0, 0), cB, voffB); PG8_STAGE(PG8_SB(0, 1), cB + hstepB, voffB); PG8_STAGE(PG8_SA(0, 0), cA, voffA); PG8_STAGE(PG8_SA(0, 1), cA + hstepA, voffA);
        if (wr == 1) PG8_BAR;
        PG8_WAIT_V(2); PG8_BAR;
        PG8_STAGE(PG8_SB(1, 0), cB + kstepB, voffB); PG8_STAGE(PG8_SA(1, 0), cA + kstep, voffA); PG8_STAGE(PG8_SB(1, 1), cB + hstepB + kstepB, voffB);
        PG8_WAIT_V(6); PG8_BAR;
    } else {
        PG8_STAGE(PG8_SB(0, 0), cB, voffB); PG8_STAGE(PG8_SA(0, 0), cA, voffA); PG8_STAGE(PG8_SB(0, 1), cB + hstepB, voffB); PG8_STAGE(PG8_SA(0, 1), cA + hstepA, voffA);
        if (wr == 1) PG8_BAR;
        PG8_WAIT_V(4); PG8_BAR;
        PG8_STAGE(PG8_SB(1, 0), cB + kstepB, voffB); PG8_STAGE(PG8_SA(1, 0), cA + kstep, voffA); PG8_STAGE(PG8_SB(1, 1), cB + hstepB + kstepB, voffB);
        PG8_WAIT_V(6); PG8_BAR;
    }
    for (;;) {
        const bool has_next = S.next(ui + 1, nxt);
        const char* nA = has_next ? (const char*)g.A + (size_t)nxt.pm * tstepA : cA; const char* nB = has_next ? (const char*)g.Bt + (size_t)nxt.pn * tstep : cB;
        for (int t = 0; t < nt; t += 2) {
            const bool last = (t == nt - 2);
            const char* a1 = cA + PG8_AK(t + 1);
            const char* a2 = last ? nA : cA + PG8_AK(t + 2); const char* b2 = last ? nB : cB + (size_t)(t + 2) * kstepB;
            const char* a3 = a2 + kstep; const char* b3 = b2 + kstepB;
            if (last && has_next) S.a_ready(nxt);
            if constexpr (SP2) {
            PG8_LDB(B0, 0, 0); PG8_LDB(B1, 0, 1); PG8_SCHED; PG8_LDA(At, 0, 0); PG8_STAGE(PG8_SA(1, 1), a1 + hstepA, voffA);
            PG8_WAIT_V(8); PG8_WAIT_L(0); PG8_BAR; PG8_MMA(0, 0, At, B0); PG8_MMA(0, 1, At, B1); PG8_BAR; PG8_SCHED;
            PG8_LDA(At, 0, 1); PG8_STAGE(PG8_SB(0, 0), b2, voffB); PG8_STAGE(PG8_SB(0, 1), b2 + hstepB, voffB); PG8_STAGE(PG8_SA(0, 0), a2, voffA);
            PG8_WAIT_V(8); PG8_WAIT_L(0); PG8_BAR; PG8_MMA(1, 0, At, B0); PG8_MMA(1, 1, At, B1); PG8_BAR; PG8_SCHED;
            PG8_LDB(B0, 1, 0); PG8_LDB(B1, 1, 1); PG8_SCHED; PG8_LDA(At, 1, 0); PG8_STAGE(PG8_SA(0, 1), a2 + hstepA, voffA);
            PG8_WAIT_V(8); PG8_WAIT_L(0); PG8_BAR; PG8_MMA(0, 0, At, B0); PG8_MMA(0, 1, At, B1); PG8_BAR; PG8_SCHED;
            PG8_LDA(At, 1, 1); PG8_STAGE(PG8_SB(1, 0), b3, voffB); PG8_STAGE(PG8_SB(1, 1), b3 + hstepB, voffB); PG8_STAGE(PG8_SA(1, 0), a3, voffA);
            PG8_WAIT_V(8); PG8_WAIT_L(0); PG8_BAR; PG8_MMA(1, 0, At, B0); PG8_MMA(1, 1, At, B1); PG8_BAR; PG8_SCHED;
            } else {
            PG8_LDB(B0, 0, 0); PG8_SCHED; PG8_LDA(At, 0, 0); PG8_STAGE(PG8_SA(1, 1), a1 + hstepA, voffA);
            PG8_WAIT_L(8); PG8_BAR; PG8_WAIT_L(0); PG8_MMA(0, 0, At, B0); PG8_BAR; PG8_SCHED;
            PG8_LDB(B1, 0, 1); PG8_STAGE(PG8_SB(0, 0), b2, voffB);
            PG8_BAR; PG8_WAIT_L(0); PG8_MMA(0, 1, At, B1); PG8_BAR;
            PG8_LDA(At, 0, 1); PG8_STAGE(PG8_SA(0, 0), a2, voffA);
            PG8_BAR; PG8_WAIT_L(0); PG8_MMA(1, 0, At, B0); PG8_BAR; PG8_SCHED;
            PG8_STAGE(PG8_SB(0, 1), b2 + hstepB, voffB);
            PG8_WAIT_V(6); PG8_BAR; PG8_MMA(1, 1, At, B1); PG8_BAR;
            PG8_LDB(B0, 1, 0); PG8_SCHED; PG8_LDA(At, 1, 0); PG8_STAGE(PG8_SA(0, 1), a2 + hstepA, voffA);
            PG8_WAIT_L(8); PG8_BAR; PG8_WAIT_L(0); PG8_MMA(0, 0, At, B0); PG8_BAR; PG8_SCHED;
            PG8_LDB(B1, 1, 1); PG8_STAGE(PG8_SB(1, 0), b3, voffB);
            PG8_BAR; PG8_WAIT_L(0); PG8_MMA(0, 1, At, B1); PG8_BAR;
            PG8_LDA(At, 1, 1); PG8_STAGE(PG8_SA(1, 0), a3, voffA);
            PG8_BAR; PG8_WAIT_L(0); PG8_MMA(1, 0, At, B0); PG8_BAR; PG8_SCHED;
            PG8_STAGE(PG8_SB(1, 1), b3 + hstepB, voffB);
            PG8_WAIT_V(6); PG8_BAR; PG8_MMA(1, 1, At, B1); PG8_BAR;
            }
        }
        if constexpr (ALIGN_EPI) { if (wr == 0) PG8_BAR; }
        if constexpr (!Epi::AFTER_DRAIN) { E(acc, cur, wr, wc, fr, fq); S.done(cur); }
        if (!has_next) break;
        PG8_ACC_INIT(nxt);
        cur = nxt; cA = nA; cB = nB; ++ui;
        if constexpr (ALIGN_EPI) { if (wr == 1) PG8_BAR; }
    }
    PG8_WAIT_V(0);
    if constexpr (!ALIGN_EPI) { if (wr == 0) PG8_BAR; }
    PG8_BAR;
    if constexpr (Epi::AFTER_DRAIN) { E.fused(acc, cur, wr, wc, fr, fq, lds, wid, lane); S.done(cur); }
#undef PG8_SA
#undef PG8_SB
#undef PG8_STAGE
#undef PG8_LDA
#undef PG8_LDB
#undef PG8_MMA
#undef PG8_WAIT_V
#undef PG8_WAIT_L
#undef PG8_BAR
#undef PG8_SCHED
#undef PG8_AK
#undef PG8_ACC_INIT
}
}

constexpr int NWAVES = 8;
constexpr int S = 8192, D = 4096, NH = 32, HD = 128, DFF = 11008, NQKV = 5 * D, NGU = 2 * DFF;
constexpr float LOG2E = 1.4426950408889634f;
constexpr float QSCALE = 0.08838834764831845f * LOG2E;
constexpr float M2_QK = 11.313708498984761f * LOG2E;
#ifndef MK_PER_PHASE
#define MK_PER_PHASE 0
#endif
constexpr int N_PHASES = 17;

constexpr size_t MiB = 1u << 20;
constexpr size_t WS_CTL = 0, CTL_ZERO_BYTES = 640 * 1024;
constexpr size_t WS_KMEAN = 64 * 1024;
constexpr size_t WS_PSS = 2 * MiB;
constexpr size_t WS_WQKV = 4 * MiB;
constexpr size_t WS_WOA  = WS_WQKV + 160 * MiB;
constexpr size_t WS_WGU  = WS_WOA + 32 * MiB;
constexpr size_t WS_WDN  = WS_WGU + 344 * MiB;
constexpr size_t WS_WKV  = WS_WDN + 172 * MiB;
constexpr size_t WS_WQB  = WS_WKV + 64 * MiB;
constexpr size_t WS_WOB  = WS_WQB + 32 * MiB;
constexpr size_t WS_HN   = WS_WOB + 32 * MiB;
constexpr size_t WS_HN2  = WS_HN + 64 * MiB;
constexpr size_t WS_PROJ = WS_HN2 + 64 * MiB;
constexpr size_t WS_PART = WS_PROJ + 320 * MiB;
constexpr size_t WS_LPART = WS_PART + 192 * MiB;
constexpr size_t WS_OB   = WS_LPART + 4 * MiB;
constexpr size_t WS_X1   = WS_OB + 64 * MiB;
constexpr size_t WS_X2   = WS_X1 + 128 * MiB;
constexpr size_t WS_HID  = WS_X2 + 128 * MiB;
constexpr size_t WS_SEL  = WS_HID + 172 * MiB;
constexpr size_t WS_END  = WS_SEL + 1 * MiB;
constexpr int CW_TMO = 0, CW_CODE = 1, CW_BAR = 4096, CW_QUEUE = 8192, CW_CVTB = 8256, CW_CVTC = 8320, CW_CVTA = 8384;

constexpr int RING_OFF = 0, RING_BYTES = 131072;
constexpr int X_OFF = RING_BYTES, X_BYTES = 8192;
constexpr int LIST_OFF = X_OFF + X_BYTES, LIST_BYTES = 12288;
constexpr int LDSCTL_OFF = LIST_OFF + LIST_BYTES, MISC_OFF = LDSCTL_OFF + 320;
constexpr int BIAS_OFF = LDSCTL_OFF + 512, BIAS_BYTES = 4096;
constexpr int LDS_BYTES = BIAS_OFF + BIAS_BYTES;
#define GAS __attribute__((address_space(1)))
#define LAS __attribute__((address_space(3)))
typedef unsigned short bf16;
typedef unsigned v4u __attribute__((ext_vector_type(4)));
typedef float f32x4 __attribute__((ext_vector_type(4)));
typedef short bf16x8 __attribute__((ext_vector_type(8)));
typedef GAS unsigned gu32;
typedef GAS unsigned long long gu64;
#define RLX_AGENT __ATOMIC_RELAXED, __HIP_MEMORY_SCOPE_AGENT
#define LDS_WAIT() asm volatile("s_waitcnt lgkmcnt(0)" ::: "memory")
#define VM_WAIT() asm volatile("s_waitcnt vmcnt(0)" ::: "memory")
__device__ __forceinline__ unsigned long long rt() { return __builtin_amdgcn_s_memrealtime(); }
__device__ __forceinline__ unsigned f2bf(float f) { unsigned u = __builtin_bit_cast(unsigned, f); return (u + 0x7fffu + ((u >> 16) & 1u)) >> 16; }
__device__ __forceinline__ unsigned pk2(float lo, float hi) { return f2bf(lo) | (f2bf(hi) << 16); }

#define XB_TMO      128
#define XB_XCNT(j)  (256  + 64 * (j))
#define XB_XSUB(j)  (1280 + 64 * (j))
#define XB_XGEN(j)  (2304 + 64 * (j))
#define XB_TOP      3328
#define XB_TOPGEN   3392
#define XCD_BAR_WORDS 3456
#define XB_SPIN_CAP (1u << 18)

__device__ __forceinline__ unsigned xb_ld(unsigned* p)              { return __hip_atomic_load(p, __ATOMIC_RELAXED, __HIP_MEMORY_SCOPE_AGENT); }
__device__ __forceinline__ unsigned xb_add(unsigned* p, unsigned v) { return __hip_atomic_fetch_add(p, v, __ATOMIC_RELAXED, __HIP_MEMORY_SCOPE_AGENT); }
__device__ __forceinline__ unsigned xb_xcc_id() { return (unsigned)__builtin_amdgcn_s_getreg((3 << 11) | 20) & 0xFu; }
#define XB_SPIN(cond, bar) do { unsigned _sp = 0; while (cond) { __builtin_amdgcn_s_sleep(1); \
    if ((++_sp & 255u) == 0u) { if (xb_ld(&(bar)[XB_TMO])) break; if (_sp > XB_SPIN_CAP) { atomicAdd(&(bar)[XB_TMO], 1u); break; } } } } while (0)

struct XcdBarrier {
    unsigned* bar; unsigned x;
    volatile LAS unsigned* st;
};

__device__ __forceinline__ XcdBarrier xcd_barrier_post(unsigned* bar, volatile LAS unsigned* st) {
    XcdBarrier b; b.bar = bar; b.x = xb_xcc_id(); b.st = st;
    if (threadIdx.x == 0) (void)xb_add(&bar[XB_XCNT(b.x)], 1u);
    return b;
}
__device__ __forceinline__ void xcd_barrier_complete(unsigned* bar, unsigned x, unsigned& nloc, unsigned& nx) {
    const unsigned G = gridDim.x * gridDim.y * gridDim.z;
    unsigned sum, cnt, mine, sp = 0u;
    for (;;) {
        sum = 0u; cnt = 0u; mine = 0u;
#pragma unroll
        for (unsigned j = 0; j < 16; ++j) { const unsigned c = xb_ld(&bar[XB_XCNT(j)]); sum += c; cnt += (c > 0u) ? 1u : 0u; mine = (j == x) ? c : mine; }
        if (sum == G) break;
        __builtin_amdgcn_s_sleep(1);
        if ((++sp & 255u) == 0u) { if (xb_ld(&bar[XB_TMO])) break; if (sp > XB_SPIN_CAP) { atomicAdd(&bar[XB_TMO], 1u); break; } }
    }
    nloc = mine > 0u ? mine : 1u; nx = cnt > 0u ? cnt : 1u;
}

__device__ __forceinline__ void xcd_barrier(const XcdBarrier& b) {
    asm volatile("s_waitcnt vmcnt(0)" ::: "memory");
    __syncthreads();
    if (threadIdx.x == 0) {
        unsigned* bar = b.bar;
        __builtin_amdgcn_s_waitcnt(0);
        unsigned nloc = b.st[0], nx = b.st[1];
        if (nloc == 0u) { xcd_barrier_complete(bar, b.x, nloc, nx); b.st[0] = nloc; b.st[1] = nx; }
        const unsigned old = xb_add(&bar[XB_XSUB(b.x)], 1u);
        const unsigned gen = old / nloc;
        if (old + 1u == (gen + 1u) * nloc) {
            __builtin_amdgcn_fence(__ATOMIC_RELEASE, "agent");
            asm volatile("s_waitcnt vmcnt(0)" ::: "memory");
            const unsigned og = xb_add(&bar[XB_TOP], 1u);
            const unsigned tg = og / nx;
            if (og + 1u == (tg + 1u) * nx) xb_add(&bar[XB_TOPGEN], 1u);
            else XB_SPIN(xb_ld(&bar[XB_TOPGEN]) == tg, bar);
            __builtin_amdgcn_fence(__ATOMIC_ACQUIRE, "agent");
            xb_add(&bar[XB_XGEN(b.x)], 1u);
            asm volatile("s_waitcnt vmcnt(0)" ::: "memory");
        } else {
            XB_SPIN(xb_ld(&bar[XB_XGEN(b.x)]) == gen, bar);
            __builtin_amdgcn_fence(__ATOMIC_ACQUIRE, "agent");
            asm volatile("s_waitcnt vmcnt(0)" ::: "memory");
        }
    }
    __syncthreads();
}


typedef short s16x4 __attribute__((ext_vector_type(4)));
typedef float f32x2 __attribute__((ext_vector_type(2)));
typedef __bf16 bf16x2v __attribute__((ext_vector_type(2)));
struct Args { const float* in[16]; float* out; unsigned char* ws; int ph_lo, ph_hi; };
#define KARGS() ((const __attribute__((address_space(4))) Args*)__builtin_amdgcn_kernarg_segment_ptr())
#define INP(k) (KARGS()->in[k])
#define OUTP() (KARGS()->out)
struct Frame {
    LAS unsigned char* lds;
    volatile LAS unsigned* MISC;
    gu32* ctl;
    unsigned char* ws;
    int tid, lane, wave, vcu, G;
};
__device__ __forceinline__ unsigned pkbf(float lo, float hi) { const f32x2 v = {lo, hi}; return __builtin_bit_cast(unsigned, __builtin_convertvector(v, bf16x2v)); }
__device__ __forceinline__ float bflo(unsigned u) { return __builtin_bit_cast(float, u << 16); }
__device__ __forceinline__ float bfhi(unsigned u) { return __builtin_bit_cast(float, u & 0xffff0000u); }
__device__ __forceinline__ float wave_sum(float v) {
    v += xshf<1>(v); v += xshf<2>(v); v += xshf<4>(v); v += xshf<8>(v); v += xshf<16>(v); v += xshf<32>(v);
    return v;
}
__device__ __forceinline__ float wave_max(float v) {
    v = fmaxf(v, xshf<1>(v)); v = fmaxf(v, xshf<2>(v)); v = fmaxf(v, xshf<4>(v)); v = fmaxf(v, xshf<8>(v)); v = fmaxf(v, xshf<16>(v)); v = fmaxf(v, xshf<32>(v));
    return v;
}
__device__ __forceinline__ int t5_bucket(int n) {
    if (n < 16) return n;
    return 16 + (n >= 22) + (n >= 30) + (n >= 40) + (n >= 54) + (n >= 73) + (n >= 99) + (n >= 134) + (n >= 182) + (n >= 246) + (n >= 332) + (n >= 450) + (n >= 609) + (n >= 825) + (n >= 1117) + (n >= 1513);
}
__device__ __forceinline__ float softmax_offset(const Frame& F, const float* gq, int ngq, const float* gk, int ngk) {
    float a = 0.f, b = 0.f, c = 0.f;
    for (int i = F.lane; i < ngq; i += 64) a = fmaxf(a, fabsf(gq[i]));
    for (int i = F.lane; i < ngk; i += 64) b = fmaxf(b, fabsf(gk[i]));
    for (int i = F.lane; i < 1024; i += 64) c = fmaxf(c, fabsf(INP(1)[i]));
    return M2_QK * wave_max(a) * wave_max(b) + LOG2E * wave_max(c);
}

struct CvtItem { const float* W; bf16* WT; const float* gain; int K, N, mode, idx; };
constexpr int I_QKV = (D / 64) * (NQKV / 32), I_DD = (D / 64) * (D / 32), I_GU = (D / 64) * (NGU / 32), I_DN = (DFF / 64) * (D / 32), I_KV = (D / 64) * (2 * D / 32);
constexpr int CVT_A_END = I_QKV + I_DD + I_GU + I_DN + I_DD + I_GU;
constexpr int CVT_B_END = CVT_A_END + I_KV + I_DD;
constexpr int CVT_C_END = CVT_B_END + I_DN;
__device__ __forceinline__ CvtItem cvt_describe(const Frame& F, int it) {
    int r = it;
    if (r < I_QKV) return CvtItem{INP(4), (bf16*)(F.ws + WS_WQKV), INP(2), D, NQKV, 0, r}; r -= I_QKV;
    if (r < I_DD) return CvtItem{INP(7), (bf16*)(F.ws + WS_WOA), nullptr, D, D, 0, r}; r -= I_DD;
    if (r < I_GU) return CvtItem{INP(14), (bf16*)(F.ws + WS_WGU), INP(3), D, NGU, 1, r}; r -= I_GU;
    if (r < I_DN) return CvtItem{INP(15), (bf16*)(F.ws + WS_WDN), nullptr, DFF, D, 0, r}; r -= I_DN;
    if (r < I_DD) return CvtItem{INP(13), (bf16*)(F.ws + WS_WOB), nullptr, D, D, 0, r}; r -= I_DD;
    if (r < I_GU) return CvtItem{INP(14) + (size_t)D * NGU, (bf16*)(F.ws + WS_WGU) + (size_t)NGU * D, INP(3) + D, D, NGU, 1, r}; r -= I_GU;
    if (r < I_KV) return CvtItem{INP(9), (bf16*)(F.ws + WS_WKV), INP(8), D, 2 * D, 0, r}; r -= I_KV;
    if (r < I_DD) return CvtItem{INP(11), (bf16*)(F.ws + WS_WQB), INP(2) + D, D, D, 0, r}; r -= I_DD;
    return CvtItem{INP(15) + (size_t)DFF * D, (bf16*)(F.ws + WS_WDN) + (size_t)D * DFF, nullptr, DFF, D, 0, r};
}
__device__ __forceinline__ void cvt_load(const CvtItem& d, int lane, float (&wv)[32]) {
    const int nblk = d.N / 32, kb = d.idx / nblk, nb = d.idx % nblk, k0 = 64 * kb, n0 = 32 * nb;
#pragma unroll
    for (int i = 0; i < 8; ++i) { const f32x4 v = __builtin_nontemporal_load((const GAS f32x4*)(d.W + (size_t)(k0 + 8 * i + (lane >> 3)) * d.N + n0 + 4 * (lane & 7)));
        wv[4 * i] = v[0]; wv[4 * i + 1] = v[1]; wv[4 * i + 2] = v[2]; wv[4 * i + 3] = v[3]; }
}
__device__ __forceinline__ void cvt_store(const CvtItem& d, int lane, const float (&wv)[32], LAS float* scr) {
    const int nblk = d.N / 32, kb = d.idx / nblk, nb = d.idx % nblk, k0 = 64 * kb, n0 = 32 * nb;
#pragma unroll
    for (int i = 0; i < 8; ++i)
#pragma unroll
        for (int j = 0; j < 4; ++j) scr[(8 * i + (lane >> 3)) * 33 + 4 * (lane & 7) + j] = wv[4 * i + j];
    LDS_WAIT(); asm volatile("" ::: "memory");
    int r0 = n0;
    if (d.mode == 1) { const int up = n0 >= DFF, j = up ? n0 - DFF : n0; r0 = 256 * (j >> 7) + (up ? 128 : 0) + (j & 127); }
    const int c = lane & 7;
    f32x4 ga = {1.f, 1.f, 1.f, 1.f}, gb = {1.f, 1.f, 1.f, 1.f};
    if (d.gain != nullptr) { ga = *(const GAS f32x4*)(d.gain + k0 + 8 * c); gb = *(const GAS f32x4*)(d.gain + k0 + 8 * c + 4); }
#pragma unroll
    for (int j = 0; j < 4; ++j) { const int n = (lane >> 3) + 8 * j; const LAS float* s = scr + (8 * c) * 33 + n;
        v4u o; o.x = pkbf(s[0 * 33] * ga[0], s[1 * 33] * ga[1]); o.y = pkbf(s[2 * 33] * ga[2], s[3 * 33] * ga[3]); o.z = pkbf(s[4 * 33] * gb[0], s[5 * 33] * gb[1]); o.w = pkbf(s[6 * 33] * gb[2], s[7 * 33] * gb[3]);
        const int rr = r0 + n;
        __builtin_nontemporal_store(o, (GAS v4u*)(d.WT + ((size_t)(rr >> 8) * (d.K / 64) + kb) * 16384 + (size_t)(rr & 255) * 64 + 8 * c)); }
    LDS_WAIT(); asm volatile("" ::: "memory");
}
__device__ __forceinline__ void convert_items(Frame& F, int lo, int hi, int gw, int NGW) {
    LAS float* scr = (LAS float*)(F.lds + RING_OFF + F.wave * 16384);
    for (int it = lo + gw; it < hi; it += 2 * NGW) {
        const CvtItem a = cvt_describe(F, lo + hi - 1 - it); float wa[32]; cvt_load(a, F.lane, wa);
        const bool hasb = it + NGW < hi;
        if (hasb) { const CvtItem b = cvt_describe(F, lo + hi - 1 - (it + NGW)); float wb[32]; cvt_load(b, F.lane, wb); cvt_store(a, F.lane, wa, scr); cvt_store(b, F.lane, wb, scr); }
        else cvt_store(a, F.lane, wa, scr);
    }
}
__device__ __forceinline__ void cvt_rows(Frame& F, const float* X, bf16* xb, float* pss) {
    const int gw = F.vcu * NWAVES + F.wave, NGW = F.G * NWAVES;
    for (int m = gw; m < S; m += NGW) {
        const GAS f32x4* xr = (const GAS f32x4*)(X + (size_t)m * D) + F.lane;
        f32x4 v[16]; float s = 0.f;
#pragma unroll
        for (int j = 0; j < 16; ++j) { v[j] = xr[64 * j]; s += (v[j].x * v[j].x + v[j].y * v[j].y) + (v[j].z * v[j].z + v[j].w * v[j].w); }
        s = wave_sum(s);
        GAS unsigned long long* o8 = (GAS unsigned long long*)(xb + (size_t)m * D) + F.lane;
#pragma unroll
        for (int j = 0; j < 16; ++j) o8[64 * j] = (unsigned long long)pkbf(v[j].x, v[j].y) | ((unsigned long long)pkbf(v[j].z, v[j].w) << 32);
        if (F.lane < 16) pss[(size_t)m * 16 + F.lane] = F.lane == 0 ? s : 0.f;
    }
}
__device__ __forceinline__ void convert_queue(Frame& F, int lo, int hi, gu32* ctr) {
    LAS float* scr = (LAS float*)(F.lds + RING_OFF + F.wave * 16384);
    constexpr unsigned CH = 16u;
    unsigned c = 0u; if (F.lane == 0) c = __hip_atomic_fetch_add(ctr, CH, __ATOMIC_RELAXED, __HIP_MEMORY_SCOPE_AGENT);
    int base = lo + __builtin_amdgcn_readfirstlane((int)c);
    while (base < hi) {
        unsigned cn = 0u; if (F.lane == 0) cn = __hip_atomic_fetch_add(ctr, CH, __ATOMIC_RELAXED, __HIP_MEMORY_SCOPE_AGENT);
        const int end = base + (int)CH < hi ? base + (int)CH : hi;
        for (int it = base; it < end; it += 2) {
            const CvtItem a = cvt_describe(F, it); float wa[32]; cvt_load(a, F.lane, wa);
            if (it + 1 < end) { const CvtItem b = cvt_describe(F, it + 1); float wb[32]; cvt_load(b, F.lane, wb); cvt_store(a, F.lane, wa, scr); cvt_store(b, F.lane, wb, scr); }
            else cvt_store(a, F.lane, wa, scr);
        }
        base = lo + __builtin_amdgcn_readfirstlane((int)cn);
    }
}
__device__ __forceinline__ void p0_prologue(Frame& F) {
    const int gw = F.vcu * NWAVES + F.wave, NGW = F.G * NWAVES;
    convert_items(F, 0, I_QKV, gw, NGW);
    cvt_rows(F, INP(0), ((bf16*)(F.ws + (WS_HN))), ((float*)(F.ws + (WS_PSS))));
}

constexpr int K_OFF = 0, V_OFF = 65536;
__device__ __forceinline__ unsigned offb(unsigned row, unsigned ch) { return 256u * row + 16u * (ch ^ (((row & 3u) << 2) | ((row >> 2) & 3u))); }
__device__ __forceinline__ void stage_kv(Frame& F, const bf16* kbase, const bf16* vbase, size_t rstride, int first_valid) {
    v4u kr[8], vr[8];
#pragma unroll
    for (int it = 0; it < 8; ++it) { const int idx = F.tid + 512 * it, row = idx >> 4, ch = idx & 15;
        if (row >= first_valid) { kr[it] = *(const GAS v4u*)(kbase + (size_t)row * rstride + ch * 8); vr[it] = *(const GAS v4u*)(vbase + (size_t)row * rstride + ch * 8); }
        else { kr[it] = (v4u){0u, 0u, 0u, 0u}; vr[it] = (v4u){0u, 0u, 0u, 0u}; } }
#pragma unroll
    for (int it = 0; it < 8; ++it) { const int idx = F.tid + 512 * it, row = idx >> 4, ch = idx & 15; const unsigned o = offb(row, ch);
        *(LAS v4u*)(F.lds + K_OFF + o) = kr[it]; *(LAS v4u*)(F.lds + V_OFF + o) = vr[it]; }
}
struct KVR { v4u k[8], v[8]; };
__device__ __forceinline__ void kv_issue(KVR& R, int tid, const bf16* kbase, const bf16* vbase, size_t rstride, int first_valid) {
#pragma unroll
    for (int it = 0; it < 8; ++it) { const int idx = tid + 512 * it, row = idx >> 4, ch = idx & 15;
        if (row >= first_valid) { R.k[it] = *(const GAS v4u*)(kbase + (size_t)row * rstride + ch * 8); R.v[it] = *(const GAS v4u*)(vbase + (size_t)row * rstride + ch * 8); }
        else { R.k[it] = (v4u){0u, 0u, 0u, 0u}; R.v[it] = (v4u){0u, 0u, 0u, 0u}; } }
}
__device__ __forceinline__ void kv_commit(Frame& F, const KVR& R) {
#pragma unroll
    for (int it = 0; it < 8; ++it) { const int idx = F.tid + 512 * it, row = idx >> 4, ch = idx & 15; const unsigned o = offb(row, ch);
        *(LAS v4u*)(F.lds + K_OFF + o) = R.k[it]; *(LAS v4u*)(F.lds + V_OFF + o) = R.v[it]; }
}
struct KVH { v4u k[4], v[4]; };
__device__ __forceinline__ void kvh_issue(KVH& R, int tid, const bf16* kbase, const bf16* vbase, size_t rstride, bool zero) {
#pragma unroll
    for (int it = 0; it < 4; ++it) { const int idx = tid + 512 * it, row = idx >> 4, ch = idx & 15;
        if (!zero) { R.k[it] = *(const GAS v4u*)(kbase + (size_t)row * rstride + ch * 8); R.v[it] = *(const GAS v4u*)(vbase + (size_t)row * rstride + ch * 8); }
        else { R.k[it] = (v4u){0u, 0u, 0u, 0u}; R.v[it] = (v4u){0u, 0u, 0u, 0u}; } }
}
__device__ __forceinline__ void kvh_commit(Frame& F, const KVH& R, int half) {
#pragma unroll
    for (int it = 0; it < 4; ++it) { const int idx = F.tid + 512 * it, row = 128 * half + (idx >> 4), ch = idx & 15; const unsigned o = offb(row, ch);
        *(LAS v4u*)(F.lds + K_OFF + o) = R.k[it]; *(LAS v4u*)(F.lds + V_OFF + o) = R.v[it]; }
}
template <bool CONSTB, class Idx>
__device__ __forceinline__ void attn_pairs(Frame& F, const LAS float* lut, float cbias, const bf16x8 (&qf)[4], int jp0, int npairs, const Idx& idx, f32x4 (&o)[8], float& l, int jx = 0) {
    const int fr = F.lane & 15, fq = F.lane >> 4;
    const int kp = 8 * (fq & 1) + 4 * (fq >> 1);
    const int pr = 8 * ((fr >> 2) & 1) + 4 * (fr >> 3) + (fr & 3);
    const int tq = fr >> 2, tp = fr & 3;
    const LAS unsigned char* kbase = F.lds + K_OFF; const LAS unsigned char* vbase = F.lds + V_OFF;
    const int jlast = jp0 + npairs - 1;
    bf16x8 ka[4], kb[4];
#pragma unroll
    for (int s = 0; s < 4; ++s) { ka[s] = *(const LAS bf16x8*)(kbase + offb(32 * (jp0 ^ jx) + pr, 4 * s + fq)); kb[s] = *(const LAS bf16x8*)(kbase + offb(32 * (jp0 ^ jx) + 16 + pr, 4 * s + fq)); }
#pragma unroll 1
    for (int jp = jp0; jp <= jlast; ++jp) {
        const int ja = 2 * jp, jb = ja + 1;
        const int pa = 2 * (jp ^ jx), pb = pa + 1;
        int ix[8]; float lv[8];
        if (!CONSTB) {
#pragma unroll
            for (int i = 0; i < 4; ++i) { ix[i] = idx(16 * ja + kp + i); ix[4 + i] = idx(16 * jb + kp + i); }
#pragma unroll
            for (int i = 0; i < 8; ++i) lv[i] = lut[ix[i] < 0 ? 0 : ix[i]];
        }
        s16x4 va[4], vb[4], vc[4], vd[4];
#pragma unroll
        for (int dt = 0; dt < 4; ++dt) {
            va[dt] = __builtin_amdgcn_ds_read_tr16_b64_v4i16((LAS s16x4*)(vbase + offb(16 * pa + kp + tq, 2 * dt + (tp >> 1)) + 8 * (tp & 1)));
            vb[dt] = __builtin_amdgcn_ds_read_tr16_b64_v4i16((LAS s16x4*)(vbase + offb(16 * pb + kp + tq, 2 * dt + (tp >> 1)) + 8 * (tp & 1)));
        }
        f32x4 sa = {0.f, 0.f, 0.f, 0.f}, sb = {0.f, 0.f, 0.f, 0.f};
#pragma unroll
        for (int s = 0; s < 4; ++s) {
            sa = __builtin_amdgcn_mfma_f32_16x16x32_bf16(ka[s], qf[s], sa, 0, 0, 0);
            sb = __builtin_amdgcn_mfma_f32_16x16x32_bf16(kb[s], qf[s], sb, 0, 0, 0);
        }
        __builtin_amdgcn_sched_barrier(0);
        const int jn = (jp < jlast ? jp + 1 : jlast) ^ jx;
#pragma unroll
        for (int s = 0; s < 4; ++s) { ka[s] = *(const LAS bf16x8*)(kbase + offb(32 * jn + pr, 4 * s + fq)); kb[s] = *(const LAS bf16x8*)(kbase + offb(32 * jn + 16 + pr, 4 * s + fq)); }
        float p[8];
#pragma unroll
        for (int i = 0; i < 4; ++i) {
            if (CONSTB) { p[i] = __builtin_amdgcn_exp2f(sa[i] + cbias); p[4 + i] = __builtin_amdgcn_exp2f(sb[i] + cbias); }
            else { const float ea = __builtin_amdgcn_exp2f(sa[i] + lv[i]), eb = __builtin_amdgcn_exp2f(sb[i] + lv[4 + i]); p[i] = ix[i] < 0 ? 0.f : ea; p[4 + i] = ix[4 + i] < 0 ? 0.f : eb; }
        }
        l += ((p[0] + p[1]) + (p[2] + p[3])) + ((p[4] + p[5]) + (p[6] + p[7]));
        v4u pw; pw.x = pkbf(p[0], p[1]); pw.y = pkbf(p[2], p[3]); pw.z = pkbf(p[4], p[5]); pw.w = pkbf(p[6], p[7]);
        const bf16x8 pf = __builtin_bit_cast(bf16x8, pw);
#pragma unroll
        for (int dt = 0; dt < 4; ++dt) {
            vc[dt] = __builtin_amdgcn_ds_read_tr16_b64_v4i16((LAS s16x4*)(vbase + offb(16 * pa + kp + tq, 2 * (dt + 4) + (tp >> 1)) + 8 * (tp & 1)));
            vd[dt] = __builtin_amdgcn_ds_read_tr16_b64_v4i16((LAS s16x4*)(vbase + offb(16 * pb + kp + tq, 2 * (dt + 4) + (tp >> 1)) + 8 * (tp & 1)));
        }
#pragma unroll
        for (int dt = 0; dt < 4; ++dt) {
            const bf16x8 vf = __builtin_shufflevector(va[dt], vb[dt], 0, 1, 2, 3, 4, 5, 6, 7);
            o[dt] = __builtin_amdgcn_mfma_f32_16x16x32_bf16(vf, pf, o[dt], 0, 0, 0);
        }
#pragma unroll
        for (int dt = 0; dt < 4; ++dt) {
            const bf16x8 vf = __builtin_shufflevector(vc[dt], vd[dt], 0, 1, 2, 3, 4, 5, 6, 7);
            o[dt + 4] = __builtin_amdgcn_mfma_f32_16x16x32_bf16(vf, pf, o[dt + 4], 0, 0, 0);
        }
    }
}
constexpr float RL_NEG = -1.0e30f;
__device__ __forceinline__ void attn_pairs_rl(Frame& F, const LAS float* rlp, const bf16x8 (&qf)[4], int jp0, int npairs, f32x4 (&o)[8], float& l, int jx = 0) {
    const int fr = F.lane & 15, fq = F.lane >> 4;
    const int kp = 8 * (fq & 1) + 4 * (fq >> 1);
    const int pr = 8 * ((fr >> 2) & 1) + 4 * (fr >> 3) + (fr & 3);
    const int tq = fr >> 2, tp = fr & 3;
    const LAS unsigned char* kbase = F.lds + K_OFF; const LAS unsigned char* vbase = F.lds + V_OFF;
    const int jlast = jp0 + npairs - 1;
    bf16x8 ka[4], kb[4];
#pragma unroll
    for (int s = 0; s < 4; ++s) { ka[s] = *(const LAS bf16x8*)(kbase + offb(32 * (jp0 ^ jx) + pr, 4 * s + fq)); kb[s] = *(const LAS bf16x8*)(kbase + offb(32 * (jp0 ^ jx) + 16 + pr, 4 * s + fq)); }
    f32x4 la, lb;
    { const LAS float* rp = rlp + 32 * jp0;
#pragma unroll
      for (int i = 0; i < 4; ++i) { la[i] = rp[i]; lb[i] = rp[16 + i]; } }
#pragma unroll 1
    for (int jp = jp0; jp <= jlast; ++jp) {
        const int pa = 2 * (jp ^ jx), pb = pa + 1;
        s16x4 va[4], vb[4], vc[4], vd[4];
#pragma unroll
        for (int dt = 0; dt < 4; ++dt) {
            va[dt] = __builtin_amdgcn_ds_read_tr16_b64_v4i16((LAS s16x4*)(vbase + offb(16 * pa + kp + tq, 2 * dt + (tp >> 1)) + 8 * (tp & 1)));
            vb[dt] = __builtin_amdgcn_ds_read_tr16_b64_v4i16((LAS s16x4*)(vbase + offb(16 * pb + kp + tq, 2 * dt + (tp >> 1)) + 8 * (tp & 1)));
        }
        f32x4 sa = la, sb = lb;
#pragma unroll
        for (int s = 0; s < 4; ++s) {
            sa = __builtin_amdgcn_mfma_f32_16x16x32_bf16(ka[s], qf[s], sa, 0, 0, 0);
            sb = __builtin_amdgcn_mfma_f32_16x16x32_bf16(kb[s], qf[s], sb, 0, 0, 0);
        }
        __builtin_amdgcn_sched_barrier(0);
        const int jl = jp < jlast ? jp + 1 : jlast, jn = jl ^ jx;
#pragma unroll
        for (int s = 0; s < 4; ++s) { ka[s] = *(const LAS bf16x8*)(kbase + offb(32 * jn + pr, 4 * s + fq)); kb[s] = *(const LAS bf16x8*)(kbase + offb(32 * jn + 16 + pr, 4 * s + fq)); }
        { const LAS float* rp = rlp + 32 * jl;
#pragma unroll
          for (int i = 0; i < 4; ++i) { la[i] = rp[i]; lb[i] = rp[16 + i]; } }
        float p[8];
#pragma unroll
        for (int i = 0; i < 4; ++i) { p[i] = __builtin_amdgcn_exp2f(sa[i]); p[4 + i] = __builtin_amdgcn_exp2f(sb[i]); }
        l += ((p[0] + p[1]) + (p[2] + p[3])) + ((p[4] + p[5]) + (p[6] + p[7]));
        v4u pw; pw.x = pkbf(p[0], p[1]); pw.y = pkbf(p[2], p[3]); pw.z = pkbf(p[4], p[5]); pw.w = pkbf(p[6], p[7]);
        const bf16x8 pf = __builtin_bit_cast(bf16x8, pw);
#pragma unroll
        for (int dt = 0; dt < 4; ++dt) {
            vc[dt] = __builtin_amdgcn_ds_read_tr16_b64_v4i16((LAS s16x4*)(vbase + offb(16 * pa + kp + tq, 2 * (dt + 4) + (tp >> 1)) + 8 * (tp & 1)));
            vd[dt] = __builtin_amdgcn_ds_read_tr16_b64_v4i16((LAS s16x4*)(vbase + offb(16 * pb + kp + tq, 2 * (dt + 4) + (tp >> 1)) + 8 * (tp & 1)));
        }
#pragma unroll
        for (int dt = 0; dt < 4; ++dt) {
            const bf16x8 vf = __builtin_shufflevector(va[dt], vb[dt], 0, 1, 2, 3, 4, 5, 6, 7);
            o[dt] = __builtin_amdgcn_mfma_f32_16x16x32_bf16(vf, pf, o[dt], 0, 0, 0);
        }
#pragma unroll
        for (int dt = 0; dt < 4; ++dt) {
            const bf16x8 vf = __builtin_shufflevector(vc[dt], vd[dt], 0, 1, 2, 3, 4, 5, 6, 7);
            o[dt + 4] = __builtin_amdgcn_mfma_f32_16x16x32_bf16(vf, pf, o[dt + 4], 0, 0, 0);
        }
    }
}
template <int NP>
__device__ __forceinline__ void attn_pairs_rlu(Frame& F, const LAS float* rlp, const bf16x8 (&qf)[4], f32x4 (&o)[8], float& l) {
    constexpr int jp0 = 0, npairs = NP, jx = 0;
    const int fr = F.lane & 15, fq = F.lane >> 4;
    const int kp = 8 * (fq & 1) + 4 * (fq >> 1);
    const int pr = 8 * ((fr >> 2) & 1) + 4 * (fr >> 3) + (fr & 3);
    const int tq = fr >> 2, tp = fr & 3;
    const LAS unsigned char* kbase = F.lds + K_OFF; const LAS unsigned char* vbase = F.lds + V_OFF;
    constexpr int jlast = jp0 + npairs - 1;
    bf16x8 ka[4], kb[4];
#pragma unroll
    for (int s = 0; s < 4; ++s) { ka[s] = *(const LAS bf16x8*)(kbase + offb(32 * (jp0 ^ jx) + pr, 4 * s + fq)); kb[s] = *(const LAS bf16x8*)(kbase + offb(32 * (jp0 ^ jx) + 16 + pr, 4 * s + fq)); }
    f32x4 la, lb;
    { const LAS float* rp = rlp + 32 * jp0;
#pragma unroll
      for (int i = 0; i < 4; ++i) { la[i] = rp[i]; lb[i] = rp[16 + i]; } }
#pragma unroll
    for (int jp = jp0; jp <= jlast; ++jp) {
        const int pa = 2 * (jp ^ jx), pb = pa + 1;
        s16x4 va[4], vb[4], vc[4], vd[4];
#pragma unroll
        for (int dt = 0; dt < 4; ++dt) {
            va[dt] = __builtin_amdgcn_ds_read_tr16_b64_v4i16((LAS s16x4*)(vbase + offb(16 * pa + kp + tq, 2 * dt + (tp >> 1)) + 8 * (tp & 1)));
            vb[dt] = __builtin_amdgcn_ds_read_tr16_b64_v4i16((LAS s16x4*)(vbase + offb(16 * pb + kp + tq, 2 * dt + (tp >> 1)) + 8 * (tp & 1)));
        }
        f32x4 sa = la, sb = lb;
#pragma unroll
        for (int s = 0; s < 4; ++s) {
            sa = __builtin_amdgcn_mfma_f32_16x16x32_bf16(ka[s], qf[s], sa, 0, 0, 0);
            sb = __builtin_amdgcn_mfma_f32_16x16x32_bf16(kb[s], qf[s], sb, 0, 0, 0);
        }
        __builtin_amdgcn_sched_barrier(0);
        const int jl = jp < jlast ? jp + 1 : jlast, jn = jl ^ jx;
        { const LAS float* rp = rlp + 32 * jl;
#pragma unroll
          for (int i = 0; i < 4; ++i) { la[i] = rp[i]; lb[i] = rp[16 + i]; } }
        float p[8];
#pragma unroll
        for (int i = 0; i < 4; ++i) { p[i] = __builtin_amdgcn_exp2f(sa[i]); p[4 + i] = __builtin_amdgcn_exp2f(sb[i]); }
        l += ((p[0] + p[1]) + (p[2] + p[3])) + ((p[4] + p[5]) + (p[6] + p[7]));
        v4u pw; pw.x = pkbf(p[0], p[1]); pw.y = pkbf(p[2], p[3]); pw.z = pkbf(p[4], p[5]); pw.w = pkbf(p[6], p[7]);
        const bf16x8 pf = __builtin_bit_cast(bf16x8, pw);
#pragma unroll
        for (int dt = 0; dt < 4; ++dt) {
            vc[dt] = __builtin_amdgcn_ds_read_tr16_b64_v4i16((LAS s16x4*)(vbase + offb(16 * pa + kp + tq, 2 * (dt + 4) + (tp >> 1)) + 8 * (tp & 1)));
            vd[dt] = __builtin_amdgcn_ds_read_tr16_b64_v4i16((LAS s16x4*)(vbase + offb(16 * pb + kp + tq, 2 * (dt + 4) + (tp >> 1)) + 8 * (tp & 1)));
        }
#pragma unroll
        for (int dt = 0; dt < 4; ++dt) {
            const bf16x8 vf = __builtin_shufflevector(va[dt], vb[dt], 0, 1, 2, 3, 4, 5, 6, 7);
            o[dt] = __builtin_amdgcn_mfma_f32_16x16x32_bf16(vf, pf, o[dt], 0, 0, 0);
        }
#pragma unroll
        for (int dt = 0; dt < 4; ++dt) {
            const bf16x8 vf = __builtin_shufflevector(vc[dt], vd[dt], 0, 1, 2, 3, 4, 5, 6, 7);
            o[dt + 4] = __builtin_amdgcn_mfma_f32_16x16x32_bf16(vf, pf, o[dt + 4], 0, 0, 0);
        }
        __builtin_amdgcn_sched_barrier(0);
        if (jp < jlast) {
#pragma unroll
            for (int s = 0; s < 4; ++s) { ka[s] = *(const LAS bf16x8*)(kbase + offb(32 * jn + pr, 4 * s + fq)); kb[s] = *(const LAS bf16x8*)(kbase + offb(32 * jn + 16 + pr, 4 * s + fq)); }
        }
    }
}
__device__ __forceinline__ void o_tile_pack(const f32x4 (&o)[8], float sc, int fq, v4u (&w)[4]) {
    const bool odd = (fq & 1) != 0;
#pragma unroll
    for (int p = 0; p < 4; ++p) {
        const unsigned a0 = pkbf(o[2 * p][0] * sc, o[2 * p][1] * sc), a1 = pkbf(o[2 * p][2] * sc, o[2 * p][3] * sc);
        const unsigned b0 = pkbf(o[2 * p + 1][0] * sc, o[2 * p + 1][1] * sc), b1 = pkbf(o[2 * p + 1][2] * sc, o[2 * p + 1][3] * sc);
        const unsigned s0 = odd ? a0 : b0, s1 = odd ? a1 : b1;
        const unsigned r0 = (unsigned)xshf_i<16>((int)s0), r1 = (unsigned)xshf_i<16>((int)s1);
        w[p] = odd ? (v4u){r0, r1, b0, b1} : (v4u){a0, a1, r0, r1};
    }
}
__device__ __forceinline__ int o_tile_off(int fq, int p) { return 32 * p + ((fq & 1) ? 16 + 4 * (fq - 1) : 4 * fq); }
__device__ __forceinline__ void fp8_pack(const f32x4 (&o)[8], float sc, v4u& wa, v4u& wb) {
    int q[8];
#pragma unroll
    for (int dt = 0; dt < 8; ++dt) { int t_ = 0; t_ = __builtin_amdgcn_cvt_pk_fp8_f32(o[dt][0] * sc, o[dt][1] * sc, t_, false); t_ = __builtin_amdgcn_cvt_pk_fp8_f32(o[dt][2] * sc, o[dt][3] * sc, t_, true); q[dt] = t_; }
    wa = (v4u){(unsigned)q[0], (unsigned)q[1], (unsigned)q[2], (unsigned)q[3]}; wb = (v4u){(unsigned)q[4], (unsigned)q[5], (unsigned)q[6], (unsigned)q[7]};
}
__device__ __forceinline__ void fp8_acc1(f32x4& o, float ws, unsigned dw) {
    const f32x2 lo = __builtin_amdgcn_cvt_pk_f32_fp8((int)dw, false), hi = __builtin_amdgcn_cvt_pk_f32_fp8((int)dw, true);
    o[0] += ws * lo[0]; o[1] += ws * lo[1]; o[2] += ws * hi[0]; o[3] += ws * hi[1];
}
__device__ __forceinline__ void fp8_acc(f32x4 (&o)[8], float ws, const v4u& pa, const v4u& pb) {
    fp8_acc1(o[0], ws, pa.x); fp8_acc1(o[1], ws, pa.y); fp8_acc1(o[2], ws, pa.z); fp8_acc1(o[3], ws, pa.w);
    fp8_acc1(o[4], ws, pb.x); fp8_acc1(o[5], ws, pb.y); fp8_acc1(o[6], ws, pb.z); fp8_acc1(o[7], ws, pb.w);
    asm volatile("" : "+v"(o[0]), "+v"(o[1]), "+v"(o[2]), "+v"(o[3]), "+v"(o[4]), "+v"(o[5]), "+v"(o[6]), "+v"(o[7]));
}
__device__ __forceinline__ void load_qf(const bf16* qrow, int fq, bf16x8 (&qf)[4]) {
#pragma unroll
    for (int s = 0; s < 4; ++s) qf[s] = *(const GAS bf16x8*)(qrow + 32 * s + 8 * fq);
}

__device__ __forceinline__ const bf16* hm_row(const Frame& F, int slot, long t) { return (const bf16*)(F.ws + WS_PROJ) + ((size_t)slot * S + t) * HD; }
__device__ __forceinline__ void load_bias_table(Frame& F, float M2) {
    LAS float* bt = (LAS float*)(F.lds + BIAS_OFF);
    for (int i = F.tid; i < 32 * NH; i += 512) bt[i] = INP(1)[i] * LOG2E - M2;
}
__device__ __forceinline__ void p_dilated(Frame& F) {
    const float M2 = softmax_offset(F, INP(5), 3 * HD, INP(6), HD);
    LAS float* lut = (LAS float*)(F.lds + X_OFF);
    const LAS float* bt = (const LAS float*)(F.lds + BIAS_OFF);
    load_bias_table(F, M2);
    __syncthreads();
    const int fr = F.lane & 15, fq = F.lane >> 4, w = F.wave;
    for (int p = F.vcu; p < 8 * NH; p += F.G) {
        const int h = p >> 3, i = p & 7;
#pragma unroll 1
        for (int cc = 0; cc < 4; ++cc) {
            const int g = cc < 2 ? cc : 2, dsh = 2 * g;
            const int r = cc == 0 ? 0 : (cc == 1 ? (i >> 1) : 2 * i + (cc - 2));
            const int b0 = cc == 0 ? 8 * i : (cc == 1 ? 8 * (i & 1) : 0), nblk = cc < 2 ? 8 : 4;
            const size_t rstride = (size_t)HD << dsh;
            const int kslot = 96 + h, vslot = 128 + h, qslot = 32 * g + h;
            KVH A, B;
            kvh_issue(A, F.tid, hm_row(F, kslot, ((long)(128 * b0) << dsh) + r), hm_row(F, vslot, ((long)(128 * b0) << dsh) + r), rstride, false);
            kvh_issue(B, F.tid, hm_row(F, kslot, ((long)(128 * (b0 - 1)) << dsh) + r), hm_row(F, vslot, ((long)(128 * (b0 - 1)) << dsh) + r), rstride, b0 == 0);
            bf16x8 qn[4]; load_qf(hm_row(F, qslot, ((long)(128 * b0 + 16 * w + fr) << dsh) + r), fq, qn);
            __syncthreads();
            kvh_commit(F, A, 0); kvh_commit(F, B, 1);
            if (F.tid < 384) { const int dist = 255 - F.tid; lut[F.tid] = (dist >= 0 && dist <= 128) ? bt[t5_bucket(dist << dsh) * NH + h] : RL_NEG; }
#pragma unroll 1
            for (int b = b0; b < b0 + nblk; ++b) {
                __syncthreads();
                const bool more = b + 1 < b0 + nblk;
                if (more) kvh_issue(A, F.tid, hm_row(F, kslot, ((long)(128 * (b + 1)) << dsh) + r), hm_row(F, vslot, ((long)(128 * (b + 1)) << dsh) + r), rstride, false);
                bf16x8 qf[4];
#pragma unroll
                for (int s = 0; s < 4; ++s) qf[s] = qn[s];
                if (more) load_qf(hm_row(F, qslot, ((long)(128 * (b + 1) + 16 * w + fr) << dsh) + r), fq, qn);
                const int iq = 16 * w + fr;
                const long tq = ((long)(128 * b + iq) << dsh) + r;
                f32x4 o[8];
#pragma unroll
                for (int dt = 0; dt < 8; ++dt) o[dt] = (f32x4){0.f, 0.f, 0.f, 0.f};
                float l = 0.f;
                const int jp0 = (b == 0) ? 4 : (w >> 1);
                attn_pairs_rl(F, lut + (127 - iq + 8 * (fq & 1) + 4 * (fq >> 1)), qf, jp0, (w >> 1) + 5 - jp0, o, l, (b & 1) ? 0 : 4);
                l += xshf<16>(l); l += xshf<32>(l);
                unsigned char* po = (unsigned char*)(F.ws + WS_PART) + ((size_t)(g * NH + h) * S + tq) * 128 + 16 * fq;
                { v4u wa, wb; fp8_pack(o, 1.0f / l, wa, wb); *(GAS v4u*)(po) = wa; *(GAS v4u*)(po + 64) = wb; }
                if (fq == 0) ((float*)(F.ws + (WS_LPART)))[(size_t)(g * NH + h) * S + tq] = l;
                if (more) { __syncthreads();
                    kvh_commit(F, A, (b + 1) & 1); }
            }
        }
    }
    __syncthreads();
}
__device__ __forceinline__ void p_merge3(Frame& F) {
    const int fr = F.lane & 15, fq = F.lane >> 4;
    const unsigned char* part = (const unsigned char*)(F.ws + WS_PART); const float* lp = (const float*)(F.ws + WS_LPART);
    constexpr size_t GROW = (size_t)NH * S;
    constexpr int NIT = NH * S / 16;
    const int step = F.G * 8;
    int it = F.vcu * 8 + F.wave;
    v4u a0, b0, a1, b1, a2, b2; float l0, l1, l2;
#define M3_LOAD(IT) { const size_t ht_ = (size_t)(IT) * 16 + fr; const unsigned char* p_ = part + ht_ * 128 + 16 * fq; \
        l0 = lp[ht_]; l1 = lp[GROW + ht_]; l2 = lp[2 * GROW + ht_]; \
        a0 = *(const GAS v4u*)(p_); b0 = *(const GAS v4u*)(p_ + 64); a1 = *(const GAS v4u*)(p_ + GROW * 128); b1 = *(const GAS v4u*)(p_ + GROW * 128 + 64); \
        a2 = *(const GAS v4u*)(p_ + 2 * GROW * 128); b2 = *(const GAS v4u*)(p_ + 2 * GROW * 128 + 64); }
    if (it < NIT) M3_LOAD(it)
    for (; it < NIT; it += step) {
        const size_t ht = (size_t)it * 16 + fr;
        f32x4 o[8];
#pragma unroll
        for (int dt = 0; dt < 8; ++dt) o[dt] = (f32x4){0.f, 0.f, 0.f, 0.f};
        const float inv = 1.0f / (l0 + l1 + l2);
        fp8_acc(o, l0, a0, b0); fp8_acc(o, l1, a1, b1); fp8_acc(o, l2, a2, b2);
        if (it + step < NIT) M3_LOAD(it + step)
        bf16* po = ((bf16*)(F.ws + (WS_OB))) + ht * HD;
        v4u wv[4]; o_tile_pack(o, inv, fq, wv);
#pragma unroll
        for (int p = 0; p < 4; ++p) *(GAS v4u*)(po + o_tile_off(fq, p)) = wv[p];
    }
#undef M3_LOAD
}
__device__ __forceinline__ void top3_insert(float v, unsigned i, float& v0, float& v1, float& v2, unsigned& i0, unsigned& i1, unsigned& i2) {
    const bool g0 = v > v0 || (v == v0 && i < i0), g1 = v > v1 || (v == v1 && i < i1), g2 = v > v2 || (v == v2 && i < i2);
    const float n2 = g1 ? v1 : (g2 ? v : v2), n1 = g0 ? v0 : (g1 ? v : v1), n0 = g0 ? v : v0;
    const unsigned j2 = g1 ? i1 : (g2 ? i : i2), j1 = g0 ? i0 : (g1 ? i : i1), j0 = g0 ? i : i0;
    v0 = n0; v1 = n1; v2 = n2; i0 = j0; i1 = j1; i2 = j2;
}
__device__ __forceinline__ void p_gate(Frame& F) {
    constexpr int KH_OFF = 0, KL_OFF = 8192;
    const int fr = F.lane & 15, fq = F.lane >> 4, w = F.wave;
    const float NEGV = -3.0e38f;
    constexpr int NU = 32 * NH;
    int hcur = -1;
    bf16x8 hf[2][4], lf[2][4];
    int u = F.vcu;
    bf16x8 qn[4];
    if (u < NU) load_qf(hm_row(F, 64 + u % NH, 256 * (u / NH) + 32 * w + fr), fq, qn);
    for (int st = 0; u < NU; ++st) {
        const int c = u / NH, h = u % NH, qt = st & 1;
        if (h != hcur) {
            __syncthreads();
            { const int n = F.tid >> 4, ch = F.tid & 15;
              const GAS f32x4* src = (const GAS f32x4*)(((float*)(F.ws + (WS_KMEAN))) + (size_t)n * D + h * HD + 8 * ch);
              const f32x4 a = src[0], b = src[1];
              unsigned hi[4], lo[4];
              hi[0] = pkbf(a[0], a[1]); hi[1] = pkbf(a[2], a[3]); hi[2] = pkbf(b[0], b[1]); hi[3] = pkbf(b[2], b[3]);
              lo[0] = pkbf(a[0] - bflo(hi[0]), a[1] - bfhi(hi[0])); lo[1] = pkbf(a[2] - bflo(hi[1]), a[3] - bfhi(hi[1]));
              lo[2] = pkbf(b[0] - bflo(hi[2]), b[1] - bfhi(hi[2])); lo[3] = pkbf(b[2] - bflo(hi[3]), b[3] - bfhi(hi[3]));
              const unsigned o = offb(n, ch);
              *(LAS v4u*)(F.lds + KH_OFF + o) = (v4u){hi[0], hi[1], hi[2], hi[3]}; *(LAS v4u*)(F.lds + KL_OFF + o) = (v4u){lo[0], lo[1], lo[2], lo[3]}; }
            __syncthreads();
#pragma unroll
            for (int s = 0; s < 4; ++s) {
                hf[0][s] = *(const LAS bf16x8*)(F.lds + KH_OFF + offb(fr, 4 * s + fq)); hf[1][s] = *(const LAS bf16x8*)(F.lds + KH_OFF + offb(16 + fr, 4 * s + fq));
                lf[0][s] = *(const LAS bf16x8*)(F.lds + KL_OFF + offb(fr, 4 * s + fq)); lf[1][s] = *(const LAS bf16x8*)(F.lds + KL_OFF + offb(16 + fr, 4 * s + fq)); }
            hcur = h;
        }
        const int t = 256 * c + 32 * w + 16 * qt + fr;
        bf16x8 qf[4];
#pragma unroll
        for (int s = 0; s < 4; ++s) qf[s] = qn[s];
        const int un = qt ? u + F.G : u;
        if (un < NU) load_qf(hm_row(F, 64 + un % NH, 256 * (un / NH) + 32 * w + 16 * (qt ^ 1) + fr), fq, qn);
        f32x4 g0 = {0.f, 0.f, 0.f, 0.f}, g1 = {0.f, 0.f, 0.f, 0.f};
#pragma unroll
        for (int s = 0; s < 4; ++s) {
            g0 = __builtin_amdgcn_mfma_f32_16x16x32_bf16(hf[0][s], qf[s], g0, 0, 0, 0); g0 = __builtin_amdgcn_mfma_f32_16x16x32_bf16(lf[0][s], qf[s], g0, 0, 0, 0);
            g1 = __builtin_amdgcn_mfma_f32_16x16x32_bf16(hf[1][s], qf[s], g1, 0, 0, 0); g1 = __builtin_amdgcn_mfma_f32_16x16x32_bf16(lf[1][s], qf[s], g1, 0, 0, 0);
        }
        float v0 = NEGV, v1 = NEGV, v2 = NEGV; unsigned i0 = 0xffu, i1 = 0xffu, i2 = 0xffu;
#pragma unroll
        for (int i = 0; i < 4; ++i) { const int na = 4 * fq + i, nb = 16 + 4 * fq + i;
            top3_insert(na < c ? g0[i] : NEGV, na < c ? (unsigned)na : 0xffu, v0, v1, v2, i0, i1, i2);
            top3_insert(nb < c ? g1[i] : NEGV, nb < c ? (unsigned)nb : 0xffu, v0, v1, v2, i0, i1, i2); }
#define GATE_MERGE(M) { const float pv0 = xshf<M>(v0), pv1 = xshf<M>(v1), pv2 = xshf<M>(v2); \
            const unsigned pi0 = (unsigned)xshf_i<M>((int)i0), pi1 = (unsigned)xshf_i<M>((int)i1), pi2 = (unsigned)xshf_i<M>((int)i2); \
            top3_insert(pv0, pi0, v0, v1, v2, i0, i1, i2); top3_insert(pv1, pi1, v0, v1, v2, i0, i1, i2); top3_insert(pv2, pi2, v0, v1, v2, i0, i1, i2); }
        GATE_MERGE(16) GATE_MERGE(32)
#undef GATE_MERGE
        if (fq == 0) ((unsigned*)(F.ws + (WS_SEL)))[(size_t)h * S + t] = i0 | (i1 << 8) | (i2 << 16) | 0xff000000u;
        u = un;
    }
    __syncthreads();
}
__constant__ unsigned char PB_ITEMS[54][3] = {{7,8,20},{0,3,7},{2,3,7},{9,10,25},{1,5,12},{4,5,12},{0,7,17},{2,7,17},{6,7,17},{3,9,22},{8,9,22},{10,11,27},{1,2,5},{5,6,14},{3,4,9},{1,12,28},{4,12,28},{11,12,28},{12,13,29},{5,14,30},{13,14,30},{14,15,31},{15,16,32},{0,1,3},{0,17,32},{2,17,32},{6,17,32},{16,17,32},{17,18,32},{18,19,32},{7,20,32},{19,20,32},{20,21,32},{3,22,32},{8,22,32},{21,22,32},{22,23,32},{23,24,32},{9,25,32},{24,25,32},{25,26,32},{10,27,32},{26,27,32},{1,28,32},{4,28,32},{11,28,32},{27,28,32},{12,29,32},{28,29,32},{5,30,32},{13,30,32},{29,30,32},{14,31,32},{30,31,32}};
__constant__ unsigned char PB_CLASS[8][7] = {{0,17,16,31,35,45,51},{2,13,18,29,33,43,255},{1,14,15,30,34,44,49},{3,12,22,26,36,46,47},{5,9,23,27,32,48,53},{4,11,21,25,39,40,255},{8,6,19,28,37,42,50},{7,10,20,24,38,41,52}};
constexpr int N_PB = 54, PB_NSEL = 8;
__device__ __forceinline__ void build_lut_moba(Frame& F, int h, int n) {
    LAS float* lut = (LAS float*)(F.lds + X_OFF);
    const LAS float* bt = (const LAS float*)(F.lds + BIAS_OFF);
    for (int i = F.tid; i < n; i += 512) lut[i] = bt[t5_bucket(i) * NH + h];
}
constexpr int RL_CP = 1791;
__device__ __forceinline__ void build_rl_own(Frame& F, int h) {
    LAS float* rl = (LAS float*)(F.lds + X_OFF);
    const LAS float* bt = (const LAS float*)(F.lds + BIAS_OFF);
    { const int i = F.tid, dist = 255 - i; rl[i] = dist >= 0 ? bt[t5_bucket(dist) * NH + h] : RL_NEG; }
}
__device__ __forceinline__ void build_rl_past(Frame& F, int h) {
    LAS float* rl = (LAS float*)(F.lds + X_OFF);
    const LAS float* bt = (const LAS float*)(F.lds + BIAS_OFF);
    for (int i = F.tid; i < 2048; i += 512) { const int dist = RL_CP - i; rl[i] = bt[t5_bucket(dist < 0 ? 0 : dist) * NH + h]; }
}
struct PbItem { int h, n, c_lo, c_hi; };
__device__ __forceinline__ PbItem pb_decode(int it) { PbItem x; const int k = it / NH; x.h = it % NH; x.n = PB_ITEMS[k][0]; x.c_lo = PB_ITEMS[k][1]; x.c_hi = PB_ITEMS[k][2]; return x; }
__device__ __forceinline__ void pb_issue(Frame& F, const PbItem& x, KVR& R) {
    kv_issue(R, F.tid, hm_row(F, x.h, 256 * x.n), hm_row(F, 32 + x.h, 256 * x.n), (size_t)HD, 0);
}
__device__ __forceinline__ void pb_sel(Frame& F, const PbItem& x, unsigned (&selr)[PB_NSEL]) {
    const int ncand = 256 * (x.c_hi - x.c_lo);
#pragma unroll
    for (int k = 0; k < PB_NSEL; ++k) { const int i = F.tid + 512 * k; selr[k] = i < ncand ? ((const unsigned*)(F.ws + WS_SEL))[(size_t)x.h * S + 256 * x.c_lo + i] : 0xffffffffu; }
}
template <int VAR>
__device__ __forceinline__ void p_past(Frame& F) {
    const float M2 = softmax_offset(F, INP(12), HD, INP(10), HD);
    LAS float* lut = (LAS float*)(F.lds + X_OFF);
    LAS unsigned short* list = (LAS unsigned short*)(F.lds + LIST_OFF);
    LAS unsigned* cntp = (LAS unsigned*)(F.lds + LDSCTL_OFF);
    const int fr = F.lane & 15, fq = F.lane >> 4;
    constexpr int NI = N_PB * NH;
    const bool packed = (F.G == 256);
    auto item_at = [&](int j) -> int { if (!packed) { const int i = F.vcu + j * F.G; return i < NI ? i : -1; }
        if (j >= 7) return -1; const int k = PB_CLASS[F.vcu >> 5][j]; return k == 255 ? -1 : k * NH + (F.vcu & 31); };
    int js = 0; int it = item_at(0);
    load_bias_table(F, M2);
    __syncthreads();
    build_rl_past(F, F.vcu % NH);
    const LAS float* btc = (const LAS float*)(F.lds + BIAS_OFF);
    KVR R;
    if (it >= 0) pb_issue(F, pb_decode(it), R);
    for (; it >= 0; it = item_at(++js)) {
        const PbItem x = pb_decode(it);
        const int h = x.h, n = x.n;
        unsigned selr[PB_NSEL]; pb_sel(F, x, selr);
        if (F.tid == 0) *cntp = 0u;
        kv_commit(F, R);
        if (h != F.vcu % NH) build_rl_past(F, h);
        __syncthreads();
        const int ncand = 256 * (x.c_hi - x.c_lo);
#pragma unroll
        for (int k = 0; k < PB_NSEL; ++k) {
            if (512 * k < ncand) {
                const int i = F.tid + 512 * k; const unsigned s = selr[k];
                const int slot = (i >= ncand) ? -1 : (((s & 0xffu) == (unsigned)n) ? 0 : ((((s >> 8) & 0xffu) == (unsigned)n) ? 1 : ((((s >> 16) & 0xffu) == (unsigned)n) ? 2 : -1)));
                const unsigned long long mask = __ballot(slot >= 0);
                unsigned base = 0u;
                if (F.lane == 0 && mask != 0ull) base = __hip_atomic_fetch_add(cntp, (unsigned)__popcll(mask), __ATOMIC_RELAXED, __HIP_MEMORY_SCOPE_WORKGROUP);
                base = (unsigned)__builtin_amdgcn_readfirstlane((int)base);
                if (slot >= 0) list[base + (unsigned)__popcll(mask & ((1ull << F.lane) - 1ull))] = (unsigned short)((unsigned)i | ((unsigned)slot << 13));
            }
        }
        __syncthreads();
        const int cnt = (int)*cntp, ntile = (cnt + 15) >> 4;
        int ti = F.wave;
        unsigned entn = 0u; bf16x8 qn[4];
        const int tb0 = 256 * x.c_lo;
        if (ti < ntile) { const int e = 16 * ti + fr; entn = list[e < cnt ? e : 0]; load_qf(hm_row(F, 64 + h, (long)(tb0 + (int)(entn & 0x1fffu))), fq, qn); }
        while (ti < ntile) {
            const unsigned ent = entn; const bool valid = (16 * ti + fr) < cnt;
            bf16x8 qf[4];
#pragma unroll
            for (int s = 0; s < 4; ++s) qf[s] = qn[s];
            const int tn = ti + NWAVES;
            if (tn < ntile) { const int e = 16 * tn + fr; entn = list[e < cnt ? e : 0]; load_qf(hm_row(F, 64 + h, (long)(tb0 + (int)(entn & 0x1fffu))), fq, qn); }
            const int t = tb0 + (int)(ent & 0x1fffu), slot = (int)(ent >> 13);
            f32x4 o[8];
#pragma unroll
            for (int dt = 0; dt < 8; ++dt) o[dt] = (f32x4){0.f, 0.f, 0.f, 0.f};
            float l = 0.f;
            const int tbase = t - 256 * n;
            if (VAR != 3) { const int jb = RL_CP - tbase; attn_pairs_rlu<8>(F, lut + ((jb < 0 ? 0 : jb) + 8 * (fq & 1) + 4 * (fq >> 1)), qf, o, l); }
            else { l = __builtin_bit_cast(float, (int)qf[0][0] + (int)qf[1][1] + (int)qf[2][2] + (int)qf[3][3]); }
            l += xshf<16>(l); l += xshf<32>(l);
            if (valid && (VAR != 2 || l == 12345.678f)) {
                int fqo = fq; asm volatile("" : "+v"(fqo));
                const float invl = 1.0f / l;
                v4u wa, wb;
                { int q0 = 0, q1 = 0, q2 = 0, q3 = 0, q4 = 0, q5 = 0, q6 = 0, q7 = 0;
#define FP8_DW(q, dt) q = __builtin_amdgcn_cvt_pk_fp8_f32(o[dt][0] * invl, o[dt][1] * invl, q, false); q = __builtin_amdgcn_cvt_pk_fp8_f32(o[dt][2] * invl, o[dt][3] * invl, q, true);
                  FP8_DW(q0, 0) FP8_DW(q1, 1) FP8_DW(q2, 2) FP8_DW(q3, 3) FP8_DW(q4, 4) FP8_DW(q5, 5) FP8_DW(q6, 6) FP8_DW(q7, 7)
#undef FP8_DW
                  wa = (v4u){(unsigned)q0, (unsigned)q1, (unsigned)q2, (unsigned)q3}; wb = (v4u){(unsigned)q4, (unsigned)q5, (unsigned)q6, (unsigned)q7}; }
                unsigned char* po = (unsigned char*)(F.ws + WS_PART) + ((size_t)(slot * NH + h) * S + t) * 128 + 16 * fqo;
                *(GAS v4u*)(po) = wa; *(GAS v4u*)(po + 64) = wb;
                if (fq == 0) ((float*)(F.ws + (WS_LPART)))[(size_t)(slot * NH + h) * S + t] = l;
            }
            ti = tn;
        }
        { const int itn = item_at(js + 1); if (itn >= 0) pb_issue(F, pb_decode(itn), R); }
        __syncthreads();
    }
}
__device__ __forceinline__ void own_issue(Frame& F, int u, KVR& R) {
    const int c = u / NH, h = u % NH;
    kv_issue(R, F.tid, hm_row(F, h, 256 * c), hm_row(F, 32 + h, 256 * c), (size_t)HD, 0);
}
__device__ __forceinline__ void p_own(Frame& F) {
    const float M2 = softmax_offset(F, INP(12), HD, INP(10), HD);
    LAS float* lut = (LAS float*)(F.lds + X_OFF);
    const int fr = F.lane & 15, fq = F.lane >> 4, w = F.wave;
    constexpr int NU = 32 * NH;
    int u = F.vcu;
    load_bias_table(F, M2);
    __syncthreads();
    build_rl_own(F, F.vcu % NH);
    KVR R;
    bf16x8 qnx[4];
    if (u < NU) { own_issue(F, u, R); load_qf(hm_row(F, 64 + u % NH, 256 * (u / NH) + 16 * w + fr), fq, qnx); }
    for (; u < NU; u += F.G) {
        const int c = u / NH, h = u % NH;
        kv_commit(F, R);
        if (h != F.vcu % NH) build_rl_own(F, h);
        __syncthreads();
        const int nslot = c < 3 ? c : 3;
        bf16x8 qa[4], qbf[4];
#pragma unroll
        for (int s = 0; s < 4; ++s) qa[s] = qnx[s];
#pragma unroll
        for (int pass = 0; pass < 2; ++pass) {
            const int qt = pass == 0 ? w : 15 - w, iq = 16 * qt + fr, t = 256 * c + iq;
            f32x4 o[8];
#pragma unroll
            for (int dt = 0; dt < 8; ++dt) o[dt] = (f32x4){0.f, 0.f, 0.f, 0.f};
            float l = 0.f;
            const LAS float* rlp = lut + (255 - iq + 8 * (fq & 1) + 4 * (fq >> 1));
            if (pass == 0) attn_pairs_rl(F, rlp, qa, 0, (qt >> 1) + 1, o, l); else attn_pairs_rl(F, rlp, qbf, 0, (qt >> 1) + 1, o, l);
            l += xshf<16>(l); l += xshf<32>(l);
            if (pass == 0) load_qf(hm_row(F, 64 + h, 256 * c + 16 * (15 - w) + fr), fq, qbf);
            v4u pa[3], pb[3]; float lp[3];
#pragma unroll
            for (int s = 0; s < 3; ++s) {
                if (s < nslot) { lp[s] = ((const float*)(F.ws + WS_LPART))[(size_t)(s * NH + h) * S + t];
                    const unsigned char* p = (const unsigned char*)(F.ws + WS_PART) + ((size_t)(s * NH + h) * S + t) * 128 + 16 * fq;
                    pa[s] = *(const GAS v4u*)(p); pb[s] = *(const GAS v4u*)(p + 64); }
                else { lp[s] = 0.f; pa[s] = (v4u){0u, 0u, 0u, 0u}; pb[s] = (v4u){0u, 0u, 0u, 0u}; }
            }
#pragma unroll
            for (int s = 0; s < 3; ++s) { l += lp[s]; const float ws = lp[s];
#define FP8_ACC(dw, dt) { const int q_ = (int)(dw); const f32x2 lo_ = __builtin_amdgcn_cvt_pk_f32_fp8(q_, false), hi_ = __builtin_amdgcn_cvt_pk_f32_fp8(q_, true); o[dt][0] += ws * lo_[0]; o[dt][1] += ws * lo_[1]; o[dt][2] += ws * hi_[0]; o[dt][3] += ws * hi_[1]; }
                FP8_ACC(pa[s].x, 0) FP8_ACC(pa[s].y, 1) FP8_ACC(pa[s].z, 2) FP8_ACC(pa[s].w, 3) FP8_ACC(pb[s].x, 4) FP8_ACC(pb[s].y, 5) FP8_ACC(pb[s].z, 6) FP8_ACC(pb[s].w, 7)
                asm volatile("" : "+v"(o[0]), "+v"(o[1]), "+v"(o[2]), "+v"(o[3]), "+v"(o[4]), "+v"(o[5]), "+v"(o[6]), "+v"(o[7]));
#undef FP8_ACC
            }
            const float inv = 1.0f / l;
            bf16* po = ((bf16*)(F.ws + (WS_OB))) + ((size_t)h * S + t) * HD;
            { v4u wv[4]; o_tile_pack(o, inv, fq, wv);
#pragma unroll
              for (int p = 0; p < 4; ++p) *(GAS v4u*)(po + o_tile_off(fq, p)) = wv[p]; }
        }
        if (u + F.G < NU) { const int un = u + F.G; own_issue(F, un, R); load_qf(hm_row(F, 64 + un % NH, 256 * (un / NH) + 16 * w + fr), fq, qnx); }
        __syncthreads();
    }
}
#ifndef EN_P0
#define EN_P0 1
#endif
#ifndef EN_P1
#define EN_P1 1
#endif
#ifndef EN_P2
#define EN_P2 1
#endif
#ifndef EN_P3
#define EN_P3 1
#endif
#ifndef EN_P8
#define EN_P8 1
#endif
#ifndef EN_P9
#define EN_P9 1
#endif
#ifndef EN_P10
#define EN_P10 1
#endif
#ifndef EN_P11
#define EN_P11 1
#endif
#ifndef EN_P12
#define EN_P12 1
#endif
#ifndef EN_PWO
#define EN_PWO 1
#endif
#ifndef EN_PN
#define EN_PN 1
#endif
#ifndef EN_PGU
#define EN_PGU 1
#endif
#ifndef EN_PDN
#define EN_PDN 1
#endif


#if defined(PROBE_GEMM) || defined(PROBE_INLINE_GEMM)
namespace pg8 {
struct EpiNull { static constexpr bool PERM = true, AFTER_DRAIN = false, INIT_BASE = false; bf16_t* O;
    __device__ __forceinline__ void operator()(const f32x4 (&acc)[2][2][4][2], const Unit& u, int wr, int wc, int fr, int fq) const {
        float s = 0.f;
#pragma unroll
        for (int ai = 0; ai < 2; ++ai)
#pragma unroll
            for (int bj = 0; bj < 2; ++bj)
#pragma unroll
                for (int m = 0; m < 4; ++m)
#pragma unroll
                    for (int n = 0; n < 2; ++n) s += acc[ai][bj][m][n][0] + acc[ai][bj][m][n][1] + acc[ai][bj][m][n][2] + acc[ai][bj][m][n][3];
        if (s == 12345.678f) O[u.pm * 7 + u.pn] = 1; } };
struct EpiPlain { static constexpr bool PERM = true, AFTER_DRAIN = false, INIT_BASE = false; bf16_t* O; int ldc;
    __device__ __forceinline__ void operator()(const f32x4 (&acc)[2][2][4][2], const Unit& u, int wr, int wc, int fr, int fq) const {
        const int row0 = u.pm * BM + wr * 64 + fr, col0 = u.pn * BM + wc * 32 + 8 * fq;
#pragma unroll
        for (int ai = 0; ai < 2; ++ai)
#pragma unroll
            for (int m = 0; m < 4; ++m) { bf16_t* rowp = O + (size_t)(row0 + ai * HALF + m * 16) * ldc + col0;
#pragma unroll
                for (int bj = 0; bj < 2; ++bj) { const f32x4 v0 = acc[ai][bj][m][0], v1 = acc[ai][bj][m][1];
                    u32x4 w; w.x = cvt_pk_bf16(v0[0], v0[1]); w.y = cvt_pk_bf16(v0[2], v0[3]); w.z = cvt_pk_bf16(v1[0], v1[1]); w.w = cvt_pk_bf16(v1[2], v1[3]);
                    *(u32x4*)(rowp + bj * HALF) = w; } } } };
}
#endif
#ifdef PROBE_GEMM
template <int V>
__global__ void __launch_bounds__(NWAVES * 64, 2) probe_gemm(Args args) {
    extern __shared__ __attribute__((aligned(16))) unsigned char lds[];
    LAS unsigned char* ring = (LAS unsigned char*)lds;
    unsigned char* ws = args.ws;
    pg8::Gemm g{(bf16*)(ws + WS_HN), (bf16*)(ws + WS_WQKV), S, NQKV, D}; pg8::StaticOrder So; So.init(S, NQKV, gridDim.x, (int)blockIdx.x);
    if (V == 0) { pg8::EpiNull E{(bf16*)(ws + WS_PROJ)}; pg8::gemm_phase<pg8::EpiNull, pg8::StaticOrder, true, true>(ring, g, So, E); }
    if (V == 1) { pg8::EpiPlain E{(bf16*)(ws + WS_PROJ), NQKV}; pg8::gemm_phase<pg8::EpiPlain, pg8::StaticOrder, true, true>(ring, g, So, E); }
    if (V == 2) { pg8::EpiNull E{(bf16*)(ws + WS_PROJ)}; pg8::gemm_phase<pg8::EpiNull, pg8::StaticOrder, false, true>(ring, g, So, E); }
    if (V == 3) { pg8::EpiPlain E{(bf16*)(ws + WS_PROJ), NQKV}; pg8::gemm_phase<pg8::EpiPlain, pg8::StaticOrder, false, true>(ring, g, So, E); }
}
#define XG(V) { static bool once_g##V = false; if (!once_g##V) { once_g##V = true; (void)hipFuncSetAttribute((const void*)probe_gemm<V>, hipFuncAttributeMaxDynamicSharedMemorySize, LDS_BYTES); } \
    hipLaunchKernelGGL((probe_gemm<V>), dim3(grid), dim3(NWAVES * 64), LDS_BYTES, stream, a); }
#endif
template <int PH_LO, int PH_HI>
__global__ void __launch_bounds__(NWAVES * 64, 2) yoco_fwd(Args args) {
    extern __shared__ __attribute__((aligned(16))) unsigned char lds[];
    Frame F;
    F.lds = (LAS unsigned char*)lds;
    F.MISC = (volatile LAS unsigned*)(F.lds + MISC_OFF);
    F.tid = threadIdx.x; F.lane = F.tid & 63; F.wave = __builtin_amdgcn_readfirstlane(F.tid >> 6);
    F.G = gridDim.x; { const int bx = blockIdx.x; F.vcu = (F.G % 8 == 0) ? (bx % 8) * (F.G / 8) + bx / 8 : bx; }
    unsigned char* ws = args.ws; F.ws = ws;
    F.ctl = (gu32*)(ws + WS_CTL);
    for (int u = F.tid; u < (LDS_BYTES - LDSCTL_OFF) / 4; u += NWAVES * 64) ((LAS unsigned*)(F.lds + LDSCTL_OFF))[u] = 0u;
    __syncthreads();
    XcdBarrier bar; bar.bar = (unsigned*)(F.ctl + CW_BAR); bar.x = 0; bar.st = nullptr;
    if (PH_HI - PH_LO > 1) bar = xcd_barrier_post((unsigned*)(F.ctl + CW_BAR), F.MISC + 8);
#ifdef PROBE_DOUBLE_BAR
#define GRID_BAR() do { if (PH_HI - PH_LO > 1) { xcd_barrier(bar); xcd_barrier(bar); } } while (0)
#else
#define GRID_BAR() do { if (PH_HI - PH_LO > 1) xcd_barrier(bar); } while (0)
#endif
    constexpr int lo = PH_LO, hi = PH_HI;
#define IN(k) (lo <= (k) && (k) < hi)
#define NEXTP(k) (((k) == 4 || (k) == 7 || (k) == 13) ? (k) + 2 : (k) + 1)
#define SEAM(k) do { if (IN(k) && IN(NEXTP(k))) GRID_BAR(); } while (0)
    LAS unsigned char* ring = F.lds + RING_OFF;
#define PHF(P) Frame P = F; { int t_ = F.tid; asm volatile("" : "+v"(t_)); t_ &= 511; P.tid = t_; P.lane = t_ & 63; }
    LAS float* xch = (LAS float*)(F.lds + X_OFF);
    LAS float* rtab = (LAS float*)(F.lds + LIST_OFF);
#define RT_RESET() do { if (F.tid == 0) rtab[0] = __int_as_float(-1); } while (0)

    if (EN_P0 && IN(0)) { PHF(P) p0_prologue(P); }
#ifdef PROBE_DOUBLE_P0
    GRID_BAR(); { PHF(P) p0_prologue(P); }
#endif
    SEAM(0);
    if (EN_P1 && IN(1)) {
        pg8::Gemm g{((bf16*)(F.ws + (WS_HN))), ((bf16*)(F.ws + (WS_WQKV))), S, NQKV, D}; pg8::RangeOrder So; So.init(S, NQKV, F.G, (int)blockIdx.x);
        pg8::EpiHeadNorm E{((bf16*)(F.ws + (WS_PROJ))), S, 0, 48, 4, 48, 16, INP(5), INP(6), QSCALE, nullptr, xch, ((float*)(F.ws + (WS_PSS))), rtab}; RT_RESET();
        const int ksplit = (10 * ((int)blockIdx.x & 7) + 3) / 7;
#pragma unroll 1
        for (int part = 0; part < 2; ++part) {
            So.i0 = part ? ksplit : 0; So.i1 = part ? (1 << 20) : ksplit;
            pg8::gemm_phase<pg8::EpiHeadNorm, pg8::RangeOrder, true, true>(ring, g, So, E);
            if (part == 0) { { PHF(P) convert_items(P, I_QKV, CVT_A_END, P.vcu * NWAVES + P.wave, P.G * NWAVES); } __syncthreads(); }
        }
#ifdef PROBE_DOUBLE_P1
        GRID_BAR(); RT_RESET(); So.i0 = 0; pg8::gemm_phase<pg8::EpiHeadNorm, pg8::RangeOrder, true, true>(ring, g, So, E);
#endif
        } SEAM(1);
#ifdef PROBE_INLINE_GEMM
    { GRID_BAR(); pg8::Gemm g{((bf16*)(F.ws + (WS_HN))), ((bf16*)(F.ws + (WS_WQKV))), S, PROBE_INLINE_GEMM, D}; pg8::StaticOrder So; So.init(S, PROBE_INLINE_GEMM, F.G, (int)blockIdx.x);
      pg8::EpiNull E{((bf16*)(F.ws + (WS_HID)))}; pg8::gemm_phase<pg8::EpiNull, pg8::StaticOrder, true, true>(ring, g, So, E); }
#endif
    if (EN_P2 && IN(2)) { PHF(P) p_dilated(P); }
#ifdef PROBE_DOUBLE_P2
    GRID_BAR(); { PHF(P) p_dilated(P); }
#endif
    SEAM(2);
    if (EN_P3 && IN(3)) { PHF(P) p_merge3(P); }
#ifdef PROBE_DOUBLE_P3
    GRID_BAR(); { PHF(P) p_merge3(P); }
#endif
    SEAM(3);
#ifdef PROBE_DOUBLE_GU
#define PROBE_REP_GU GRID_BAR(); RT_RESET(); pg8::gemm_phase<pg8::EpiSwiGLU, pg8::StaticOrder, true, true>(ring, g, So, E);
#else
#define PROBE_REP_GU
#endif
#define LAYER_TAIL(l) { const int pb = l ? 13 : 4; \
        if (EN_PWO && IN(pb)) { pg8::Gemm g{((bf16*)(F.ws + (WS_OB))), l ? ((bf16*)(F.ws + (WS_WOB))) : ((bf16*)(F.ws + (WS_WOA))), S, D, D}; pg8::StaticOrder So; So.init(S, D, F.G, (int)blockIdx.x); \
            pg8::EpiResNorm E{((bf16*)(F.ws + (WS_HN))), D, nullptr, ((float*)(F.ws + (WS_PSS))), xch}; \
            pg8::gemm_phase<pg8::EpiResNorm, pg8::StaticOrder, true, true, true>(ring, g, So, E); } SEAM(pb); \
        if (EN_PGU && IN(pb + 2)) { const int nhlp = 0;     \
            if ((int)blockIdx.x >= F.G - nhlp) { PHF(P) convert_items(P, CVT_B_END, CVT_C_END, ((int)blockIdx.x - (F.G - nhlp)) * NWAVES + P.wave, nhlp * NWAVES); } \
            else { pg8::Gemm g{((bf16*)(F.ws + (WS_HN))), ((bf16*)(F.ws + (WS_WGU))) + (size_t)l * NGU * D, S, NGU, D}; pg8::StaticOrder So; So.init(S, NGU, F.G - nhlp, (int)blockIdx.x); \
            pg8::EpiSwiGLU E{((bf16*)(F.ws + (WS_HID))), DFF, ((float*)(F.ws + (WS_PSS))), rtab}; RT_RESET(); \
            pg8::gemm_phase<pg8::EpiSwiGLU, pg8::StaticOrder, true, true>(ring, g, So, E); PROBE_REP_GU } \
            { PHF(P) convert_queue(P, l ? CVT_B_END : CVT_A_END, l ? CVT_C_END : CVT_B_END, F.ctl + (l ? CW_CVTC : CW_CVTB)); } } SEAM(pb + 2); \
        if (EN_PDN && IN(pb + 3)) { pg8::Gemm g{((bf16*)(F.ws + (WS_HID))), ((bf16*)(F.ws + (WS_WDN))) + (size_t)l * D * DFF, S, D, DFF}; pg8::StaticOrder So; So.init(S, D, F.G, (int)blockIdx.x); \
            pg8::EpiResNorm E{((bf16*)(F.ws + (WS_HN))), D, l ? OUTP() : (float*)nullptr, ((float*)(F.ws + (WS_PSS))), xch}; \
            pg8::gemm_phase<pg8::EpiResNorm, pg8::StaticOrder, true, true>(ring, g, So, E); } }
    LAYER_TAIL(0)
    SEAM(7);
    if (EN_P9 && IN(9)) { pg8::Gemm g{((bf16*)(F.ws + (WS_HN))), ((bf16*)(F.ws + (WS_WKV))), S, 3 * D, D}; pg8::StaticOrder So; So.init(S, 3 * D, F.G, (int)blockIdx.x);
        pg8::EpiHeadNorm E{((bf16*)(F.ws + (WS_PROJ))), S, 32, 16, 31, 0, 16, INP(12), INP(10), QSCALE, ((float*)(F.ws + (WS_KMEAN))), xch, ((float*)(F.ws + (WS_PSS))), rtab}; RT_RESET();
        pg8::gemm_phase<pg8::EpiHeadNorm, pg8::StaticOrder, true, true>(ring, g, So, E);
#ifdef PROBE_DOUBLE_P9
        GRID_BAR(); RT_RESET(); pg8::gemm_phase<pg8::EpiHeadNorm, pg8::StaticOrder, true, true>(ring, g, So, E);
#endif
        } SEAM(9);
    if (EN_P10 && IN(10)) { PHF(P) p_gate(P); }
#ifdef PROBE_DOUBLE_GATE
    GRID_BAR(); { PHF(P) p_gate(P); } GRID_BAR(); { PHF(P) p_gate(P); } GRID_BAR(); { PHF(P) p_gate(P); } GRID_BAR(); { PHF(P) p_gate(P); }
#endif
    SEAM(10);
#ifdef PROBE_P11_VARIANT
    if (EN_P11 && IN(11)) { { PHF(P) p_past<PROBE_P11_VARIANT>(P); } GRID_BAR(); }
#endif
    if (EN_P11 && IN(11)) { PHF(P) p_past<0>(P); } SEAM(11);
    if (EN_P12 && IN(12)) { PHF(P) p_own(P); }
#ifdef PROBE_DOUBLE_P12
    GRID_BAR(); { PHF(P) p_own(P); }
#endif
    SEAM(12);
    LAYER_TAIL(1)
#undef LAYER_TAIL
#undef PHF
#undef RT_RESET
#undef IN
#undef SEAM
#undef NEXTP
#undef GRID_BAR
}

extern "C" void kernel_launch(void* const* d_in, const int* in_sizes, int n_in, void* d_out, int out_size, void* d_ws, size_t ws_size, hipStream_t stream) {
    static int grid = 0;
    if (grid == 0) {
        if (n_in != 16 || in_sizes[0] != S * D || out_size != S * D || ws_size < WS_END) { fprintf(stderr, "kernel_launch: shape/workspace mismatch: n_in %d in0 %d out %d ws %zu (need %zu)\n", n_in, n_in > 0 ? in_sizes[0] : -1, out_size, ws_size, (size_t)WS_END); grid = -1; return; }
        int dev = 0, cus = 0, per_cu = 0;
        if (hipGetDevice(&dev) != hipSuccess || hipDeviceGetAttribute(&cus, hipDeviceAttributeMultiprocessorCount, dev) != hipSuccess) { fprintf(stderr, "kernel_launch: device query failed\n"); grid = -1; return; }
#if MK_PER_PHASE
        hipError_t fe = hipSuccess;
#define SETATTR(P) if (fe == hipSuccess) fe = hipFuncSetAttribute((const void*)yoco_fwd<P, P + 1>, hipFuncAttributeMaxDynamicSharedMemorySize, LDS_BYTES);
        SETATTR(0) SETATTR(1) SETATTR(2) SETATTR(3) SETATTR(4) SETATTR(5) SETATTR(6) SETATTR(7) SETATTR(8) SETATTR(9) SETATTR(10) SETATTR(11) SETATTR(12) SETATTR(13) SETATTR(14) SETATTR(15) SETATTR(16)
#undef SETATTR
        if (fe != hipSuccess) { fprintf(stderr, "kernel_launch: hipFuncSetAttribute failed\n"); grid = -1; return; }
#else
        if (hipFuncSetAttribute((const void*)yoco_fwd<0, N_PHASES>, hipFuncAttributeMaxDynamicSharedMemorySize, LDS_BYTES) != hipSuccess) { fprintf(stderr, "kernel_launch: hipFuncSetAttribute failed\n"); grid = -1; return; }
        if (hipOccupancyMaxActiveBlocksPerMultiprocessor(&per_cu, (const void*)yoco_fwd<0, N_PHASES>, NWAVES * 64, LDS_BYTES) != hipSuccess || per_cu < 1)
            fprintf(stderr, "kernel_launch: note: occupancy query reports %d workgroups per CU\n", per_cu);
#endif
        (void)hipGetLastError();
        grid = cus;
    }
    if (grid < 0) return;
    if (hipMemsetAsync((char*)d_ws + WS_CTL, 0, CTL_ZERO_BYTES, stream) != hipSuccess) { fprintf(stderr, "kernel_launch: memset failed\n"); return; }
    Args a{};
    for (int i = 0; i < 16; ++i) a.in[i] = (const float*)d_in[i];
    a.out = (float*)d_out; a.ws = (unsigned char*)d_ws;
#if MK_PER_PHASE
#define LAUNCH(P) hipLaunchKernelGGL((yoco_fwd<P, P + 1>), dim3(grid), dim3(NWAVES * 64), LDS_BYTES, stream, a);
    LAUNCH(0) LAUNCH(1) LAUNCH(2) LAUNCH(3) LAUNCH(4) LAUNCH(5) LAUNCH(6) LAUNCH(7) LAUNCH(8) LAUNCH(9) LAUNCH(10) LAUNCH(11) LAUNCH(12) LAUNCH(13) LAUNCH(14) LAUNCH(15) LAUNCH(16)
#undef LAUNCH
#else
    hipLaunchKernelGGL((yoco_fwd<0, N_PHASES>), dim3(grid), dim3(NWAVES * 64), LDS_BYTES, stream, a);
#endif
#ifdef PROBE_GEMM
    PROBE_GEMM
#endif
#ifdef PROBE_EXTRA
#define XL(P) { static bool once_##P = false; if (!once_##P) { once_##P = true; (void)hipFuncSetAttribute((const void*)yoco_fwd<P, P + 1>, hipFuncAttributeMaxDynamicSharedMemorySize, LDS_BYTES); } \
    hipLaunchKernelGGL((yoco_fwd<P, P + 1>), dim3(grid), dim3(NWAVES * 64), LDS_BYTES, stream, a); }
#ifdef PROBE_FLAG
    a.ph_lo = PROBE_FLAG;
#endif
    PROBE_EXTRA
#undef XL
#endif
    const hipError_t le = hipPeekAtLastError();
    if (le != hipSuccess) fprintf(stderr, "kernel_launch: launch failed: %s\n", hipGetErrorName(le));
}
```
